# Optimizing an MI355X kernel written in HIP

```python
import math
import jax
import jax.numpy as jnp
from jax import lax
import numpy as np

D_MODEL = 1024
BATCH = 16
SEQ = 4096
DEPTH = 4

HEAD_DIM = 64
N_HEADS = D_MODEL // HEAD_DIM
A_HEADS = (3 * N_HEADS) // 8
A_KV_HEADS = A_HEADS // 3
B_HEADS = N_HEADS // 4
C_HEADS = N_HEADS - A_HEADS - B_HEADS
DIFF_DIM = HEAD_DIM // 2
WINDOW = 128
A_BLOCK = 128
Q_BLOCK = 128
GRID_W = 64
NA_ROWS = 8
NA_COLS = 16
T5_BUCKETS = 32
T5_MAX_DIST = 128
D_FF = 4 * D_MODEL
ALPHA = (2 * DEPTH) ** 0.25
BETA = (8 * DEPTH) ** -0.25
EPS = 1e-5
NEG = -1e30
A_Q_W = A_HEADS * HEAD_DIM
A_KV_W = A_KV_HEADS * HEAD_DIM
B_W = B_HEADS * HEAD_DIM
C_W = C_HEADS * HEAD_DIM
IN_WIDTH = A_Q_W + 2 * A_KV_W + 3 * B_W + 3 * C_W

kernel_name = "hybrid_parallel_heads_encoder"


def layer_norm(x, g=None, b=None):
    xf = x.astype(jnp.float32)
    xc = xf - xf.mean(-1, keepdims=True)
    y = xc * lax.rsqrt((xc * xc).mean(-1, keepdims=True) + EPS)
    if g is not None:
        y = y * g.astype(jnp.float32) + b.astype(jnp.float32)
    return y.astype(x.dtype)


def t5_bucket(rel):
    half = T5_BUCKETS // 2
    exact = half // 2
    n = jnp.abs(rel)
    large = exact + (jnp.log(jnp.maximum(n, 1).astype(jnp.float32) / exact)
                     / math.log(T5_MAX_DIST / exact) * (half - exact)).astype(jnp.int32)
    large = jnp.minimum(large, half - 1)
    return (rel > 0).astype(jnp.int32) * half + jnp.where(n < exact, n, large)


def split_projection(proj):
    Bn, S, _ = proj.shape
    widths = (A_Q_W, A_KV_W, A_KV_W, B_W, B_W, B_W, C_W, C_W, C_W)
    heads = (A_HEADS, A_KV_HEADS, A_KV_HEADS, B_HEADS, B_HEADS, B_HEADS, C_HEADS, C_HEADS, C_HEADS)
    out = []
    off = 0
    for w, hn in zip(widths, heads):
        out.append(proj[..., off:off + w].reshape(Bn, S, hn, HEAD_DIM))
        off += w
    return out


def windowed_gqa(q, k, v, sink, bias_tab):
    Bn, S, HA, d = q.shape
    HKV = k.shape[2]
    G = HA // HKV
    nb = S // A_BLOCK
    qb = q.reshape(Bn, nb, A_BLOCK, HKV, G, d)

    def neighbours(t):
        tp = jnp.pad(t, ((0, 0), (A_BLOCK, A_BLOCK), (0, 0), (0, 0))).reshape(Bn, nb + 2, A_BLOCK, HKV, d)
        return jnp.concatenate([tp[:, :-2], tp[:, 1:-1], tp[:, 2:]], axis=2)

    kb, vb = neighbours(k), neighbours(v)
    s = jnp.einsum('bnqhgd,bnkhd->bhgnqk', qb, kb).astype(jnp.float32) * (d ** -0.5)
    qi = jnp.arange(A_BLOCK)
    kj = jnp.arange(3 * A_BLOCK) - A_BLOCK
    rel = kj[None, :] - qi[:, None]
    bias = bias_tab[t5_bucket(rel)].astype(jnp.float32)
    bias = bias.transpose(2, 0, 1).reshape(HKV, G, 1, A_BLOCK, 3 * A_BLOCK)
    kpos = jnp.arange(nb)[:, None] * A_BLOCK + kj[None, :]
    inside = (kpos >= 0) & (kpos < S)
    valid = (jnp.abs(rel) <= WINDOW)[None] & inside[:, None, :]
    s = jnp.where(valid, s + bias, NEG)
    sk = sink.astype(jnp.float32).reshape(HKV, G, 1, 1, 1)
    m = jnp.maximum(s.max(-1, keepdims=True), sk)
    p = jnp.exp(s - m)
    p = p / (p.sum(-1, keepdims=True) + jnp.exp(sk - m))
    o = jnp.einsum('bhgnqk,bnkhd->bnqhgd', p.astype(v.dtype), vb)
    return o.reshape(Bn, S, HA * d)


def diff_attention(q, k, v, lam, lam_init, subln_g, bias_tab):
    Bn, S, H, d = q.shape
    half = d // 2
    scale = half ** -0.5
    nq = S // Q_BLOCK
    qs = q.reshape(Bn, nq, Q_BLOCK, H, d).swapaxes(0, 1)
    k1, k2 = k[..., :half], k[..., half:]
    kpos = jnp.arange(S)

    def block(args):
        qblk, i = args
        qpos = i * Q_BLOCK + jnp.arange(Q_BLOCK)
        bias = bias_tab[t5_bucket(kpos[None, :] - qpos[:, None])].astype(jnp.float32).transpose(2, 0, 1)
        s1 = jnp.einsum('bqhd,bkhd->bhqk', qblk[..., :half], k1).astype(jnp.float32) * scale + bias
        s2 = jnp.einsum('bqhd,bkhd->bhqk', qblk[..., half:], k2).astype(jnp.float32) * scale + bias
        a = jax.nn.softmax(s1, axis=-1) - lam * jax.nn.softmax(s2, axis=-1)
        return jnp.einsum('bhqk,bkhd->bqhd', a.astype(v.dtype), v)

    o = lax.map(block, (qs, jnp.arange(nq)))
    o = o.swapaxes(0, 1).reshape(Bn, S, H, d).astype(jnp.float32)
    o = o * lax.rsqrt((o * o).mean(-1, keepdims=True) + EPS) * subln_g.astype(jnp.float32) * (1.0 - lam_init)
    return o.reshape(Bn, S, H * d).astype(v.dtype)


def neighbourhood_attention(q, k, v, rpb):
    Bn, S, H, d = q.shape
    rows = S // GRID_W
    kh = min(NA_ROWS, rows)
    kw = NA_COLS
    qg = q.reshape(Bn, rows, GRID_W, H, d)
    kg = k.reshape(Bn, rows, GRID_W, H, d)
    vg = v.reshape(Bn, rows, GRID_W, H, d)
    cols = jnp.arange(GRID_W)
    cstart = jnp.clip(cols - kw // 2, 0, GRID_W - kw)
    col_valid = (cols[None, :] >= cstart[:, None]) & (cols[None, :] < cstart[:, None] + kw)
    dc_idx = jnp.clip(cols[None, :] - cols[:, None] + kw - 1, 0, 2 * kw - 2)
    scale = d ** -0.5

    def row(r):
        rs = jnp.clip(r - kh // 2, 0, rows - kh)
        k_blk = lax.dynamic_slice_in_dim(kg, rs, kh, axis=1)
        v_blk = lax.dynamic_slice_in_dim(vg, rs, kh, axis=1)
        q_row = lax.dynamic_index_in_dim(qg, r, axis=1, keepdims=False)
        s = jnp.einsum('bqhd,brkhd->bhqrk', q_row, k_blk).astype(jnp.float32) * scale
        dr_idx = rs + jnp.arange(kh) - r + NA_ROWS - 1
        b = rpb[:, dr_idx][:, :, dc_idx].astype(jnp.float32).transpose(0, 2, 1, 3)
        s = jnp.where(col_valid[:, None, :], s + b, NEG)
        p = jax.nn.softmax(s, axis=(-2, -1))
        return jnp.einsum('bhqrk,brkhd->bqhd', p.astype(v.dtype), v_blk)

    o = lax.map(row, jnp.arange(rows))
    return o.swapaxes(0, 1).reshape(Bn, S, H * d)


def setup_inputs(seed: int = 0) -> dict:
    key = jax.random.key(seed)
    ks = jax.random.split(key, 16)
    nrm = jax.random.normal
    col_scale = np.ones((IN_WIDTH,), np.float32)
    col_scale[A_Q_W + A_KV_W:A_Q_W + 2 * A_KV_W] = BETA
    col_scale[A_Q_W + 2 * A_KV_W + 2 * B_W:A_Q_W + 2 * A_KV_W + 3 * B_W] = BETA
    col_scale[IN_WIDTH - C_W:] = BETA
    return {
        "x": nrm(ks[0], (BATCH, SEQ, D_MODEL), jnp.float32),
        "c": nrm(ks[1], (BATCH, D_MODEL), jnp.float32),
        "w_ada": nrm(ks[2], (DEPTH, D_MODEL, 6 * D_MODEL), jnp.float32) * (0.1 * D_MODEL ** -0.5),
        "b_ada": nrm(ks[3], (DEPTH, 6 * D_MODEL), jnp.float32) * 0.02,
        "w_in": nrm(ks[4], (DEPTH, D_MODEL, IN_WIDTH), jnp.float32) * (D_MODEL ** -0.5) * jnp.asarray(col_scale),
        "w_out": nrm(ks[5], (DEPTH, D_MODEL, D_MODEL), jnp.float32) * (D_MODEL ** -0.5 * BETA),
        "t5_bias": nrm(ks[6], (T5_BUCKETS, A_HEADS + B_HEADS), jnp.float32) * 0.5,
        "a_sink": nrm(ks[7], (DEPTH, A_HEADS), jnp.float32) * 0.5,
        "diff_lambda": nrm(ks[8], (DEPTH, 4, DIFF_DIM), jnp.float32) * 0.1,
        "diff_subln": 1.0 + 0.02 * nrm(ks[9], (DEPTH, HEAD_DIM), jnp.float32),
        "nat_rpb": nrm(ks[10], (DEPTH, C_HEADS, 2 * NA_ROWS - 1, 2 * NA_COLS - 1), jnp.float32) * 0.5,
        "ln_g": 1.0 + 0.02 * nrm(ks[11], (DEPTH, 2, D_MODEL), jnp.float32),
        "ln_b": 0.02 * nrm(ks[12], (DEPTH, 2, D_MODEL), jnp.float32),
        "w_ff1": nrm(ks[13], (DEPTH, D_MODEL, D_FF), jnp.float32) * (D_MODEL ** -0.5),
        "w_ff2": nrm(ks[14], (DEPTH, D_FF, D_MODEL), jnp.float32) * (D_FF ** -0.5 * BETA),
    }


def reference(x, c, w_ada, b_ada, w_in, w_out, t5_bias, a_sink, diff_lambda, diff_subln,
              nat_rpb, ln_g, ln_b, w_ff1, w_ff2):
    cs = jax.nn.silu(c)
    for l in range(DEPTH):
        mod = (cs @ w_ada[l] + b_ada[l])[:, None, :]
        sh1, sc1, g1, sh2, sc2, g2 = jnp.split(mod, 6, axis=-1)
        h = layer_norm(x) * (1 + sc1) + sh1
        qa, ka, va, qb, kb, vb, qc, kc, vc = split_projection(h @ w_in[l])
        lam_init = 0.8 - 0.6 * math.exp(-0.3 * l)
        lam_v = diff_lambda[l].astype(jnp.float32)
        lam = jnp.exp(jnp.sum(lam_v[0] * lam_v[1])) - jnp.exp(jnp.sum(lam_v[2] * lam_v[3])) + lam_init
        ya = windowed_gqa(qa, ka, va, a_sink[l], t5_bias[:, :A_HEADS])
        yb = diff_attention(qb, kb, vb, lam, lam_init, diff_subln[l], t5_bias[:, A_HEADS:])
        yc = neighbourhood_attention(qc, kc, vc, nat_rpb[l])
        y = jnp.concatenate([ya, yb, yc], axis=-1) @ w_out[l]
        x = layer_norm(ALPHA * x + (1 + g1) * y, ln_g[l, 0], ln_b[l, 0])
        h = layer_norm(x) * (1 + sc2) + sh2
        f = jnp.square(jax.nn.relu(h @ w_ff1[l])) @ w_ff2[l]
        x = layer_norm(ALPHA * x + (1 + g2) * f, ln_g[l, 1], ln_b[l, 1])
    return x
```

```cpp
#include <hip/hip_runtime.h>
#include <hip/hip_cooperative_groups.h>
#include <cstdio>
#include <cstdint>
namespace cg = cooperative_groups;

#define LAS __attribute__((address_space(3)))
typedef unsigned short bf16_t;
typedef short bf16x8 __attribute__((ext_vector_type(8)));
typedef float f32x4 __attribute__((ext_vector_type(4)));
typedef float f32x16 __attribute__((ext_vector_type(16)));
typedef unsigned u32x4 __attribute__((ext_vector_type(4)));
typedef unsigned u32x2 __attribute__((ext_vector_type(2)));

constexpr int BATCH = 16, SEQ = 4096, DM = 1024, DEPTH = 4, FF = 4096, INW = 2560;
constexpr int M = BATCH * SEQ;
constexpr float LN_EPS = 1e-5f;
constexpr float ALPHA = 1.681792830507429f;
constexpr int QA = 0, KA = 384, VA = 512, QB = 640, KB = 896, VB = 1152, QC = 1408, KC = 1792, VC = 2176;
constexpr size_t MiB = 1u << 20;
constexpr size_t WS_MOD = 0;
constexpr size_t WS_LAM = WS_MOD + 1792 * 1024;
constexpr size_t WS_WIN = 2 * MiB;
constexpr size_t WS_WOUT = 22 * MiB;
constexpr size_t WS_W1 = 30 * MiB;
constexpr size_t WS_W2 = 62 * MiB;
constexpr size_t WS_HN = 96 * MiB;
constexpr size_t WS_Y = 224 * MiB;
constexpr size_t WS_R = 352 * MiB;
constexpr size_t WS_YCAT = WS_R + 320 * MiB;
constexpr size_t WS_END = WS_R + 512 * MiB;

constexpr int LDS_BYTES = 147456;

struct Params {
    const float *x, *c, *w_ada, *b_ada, *w_in, *w_out, *t5, *sink, *dlam, *subln, *rpb, *ln_g, *ln_b, *w_ff1, *w_ff2;
    float* out; unsigned char* ws;
};

__device__ __forceinline__ float bf2f(unsigned v) { return __uint_as_float(v << 16); }
__device__ __forceinline__ unsigned f2bf(float f) { unsigned u = __float_as_uint(f); return (u + 0x7fffu + ((u >> 16) & 1u)) >> 16; }
__device__ __forceinline__ unsigned pk2(float lo, float hi) { return f2bf(lo) | (f2bf(hi) << 16); }
__device__ __forceinline__ float wave_sum(float v) {
#pragma unroll
    for (int o = 1; o < 64; o <<= 1) v += __shfl_xor(v, o);
    return v;
}
__device__ __forceinline__ int t5_bucket(int rel) {
    const int n = rel < 0 ? -rel : rel;
    int b;
    if (n < 8) b = n;
    else b = 8 + (n >= 12) + (n >= 16) + (n >= 23) + (n >= 32) + (n >= 46) + (n >= 64) + (n >= 91);
    return b + (rel > 0 ? 16 : 0);
}

namespace pg8 {
constexpr int BM = 256, BK = 64, HALF = 128, HTB = HALF * BK * 2, STAGE_BYTES = 8 * HTB, NXCD = 8, WGM = 8;
__host__ __device__ __forceinline__ int lds_byte(int r, int c) { const int st = (r >> 4) * 2 + (c >> 5), rr = r & 15, cc = c & 31, ob = rr * 64 + cc * 2; return st * 1024 + (ob ^ (((ob >> 9) & 1) << 5)); }
__host__ __device__ __forceinline__ void stage_rc(int b, int& R, int& C) { const int st = b / 1024, sb = b % 1024, swz = sb ^ (((sb >> 9) & 1) << 5); R = (st >> 1) * 16 + swz / 64; C = (st & 1) * 32 + (swz % 64) / 2; }
__host__ __device__ __forceinline__ int perm32(int rho) { const int n = rho >> 4, i = rho & 15; return 8 * (i >> 2) + 4 * n + (i & 3); }

struct Unit { int pm, pn; };
struct Gemm { const bf16_t* A; const bf16_t* Bt; int M, N, K; };

struct StaticOrder {
    int nM, nN, nwg, G, c;
    __device__ void init(int M_, int N_, int G_, int c_) { nM = M_ / BM; nN = N_ / BM; nwg = nM * nN; G = G_; c = c_; }
    __device__ bool next(int i, Unit& u) const {
        const long L = (long)i * G + c; if (L >= nwg) return false;
        int wgid = (int)L; { const int q = nwg / NXCD, r = nwg % NXCD, xcd = wgid % NXCD, off = wgid / NXCD; wgid = (xcd < r ? xcd * (q + 1) : r * (q + 1) + (xcd - r) * q) + off; }
        const int nig = WGM * nN, gid = wgid / nig, fm = gid * WGM, gsz = (nM - fm) < WGM ? (nM - fm) : WGM;
        u.pm = fm + ((wgid % nig) % gsz); u.pn = (wgid % nig) / gsz; return true;
    }
};

__device__ __forceinline__ unsigned cvt_pk_bf16(float lo, float hi) { unsigned r; asm volatile("v_cvt_pk_bf16_f32 %0, %1, %2" : "=v"(r) : "v"(lo), "v"(hi)); return r; }

template <int ACT  > struct EpiBf16 {
    static constexpr bool PERM = true, AFTER_DRAIN = false;
    bf16_t* O; int ldc;
    __device__ __forceinline__ void operator()(const f32x4 (&acc)[2][2][4][2], const Unit& u, int wr, int wc, int fr, int fq) const {
        const int row0 = u.pm * BM + wr * 64 + fr; const int col0 = u.pn * BM + wc * 32 + 8 * fq;
#pragma unroll
        for (int ai = 0; ai < 2; ++ai)
#pragma unroll
            for (int m = 0; m < 4; ++m) { bf16_t* rowp = O + (size_t)(row0 + ai * HALF + m * 16) * ldc + col0;
#pragma unroll
                for (int bj = 0; bj < 2; ++bj) { f32x4 v0 = acc[ai][bj][m][0], v1 = acc[ai][bj][m][1];
                    if (ACT == 2) {
#pragma unroll
                        for (int e = 0; e < 4; ++e) { const float a = fmaxf(v0[e], 0.f), b = fmaxf(v1[e], 0.f); v0[e] = a * a; v1[e] = b * b; } }
                    u32x4 w; w.x = cvt_pk_bf16(v0[0], v0[1]); w.y = cvt_pk_bf16(v0[2], v0[3]); w.z = cvt_pk_bf16(v1[0], v1[1]); w.w = cvt_pk_bf16(v1[2], v1[3]);
                    *(u32x4*)(rowp + bj * HALF) = w; } }
    }
};

template <class Epi, class Sched, bool ALIGN_EPI = false, bool SP2 = false>
__device__ __forceinline__ void gemm_phase(LAS unsigned char* lds, const Gemm g, const Sched& S, const Epi& E) {
    int tid = threadIdx.x; asm volatile("" : "+v"(tid));
    const int wid = __builtin_amdgcn_readfirstlane(tid >> 6), lane = tid & 63, wr = wid >> 2, wc = wid & 3, fr = lane & 15, fq = lane >> 4;
    const int K = g.K, nt = K / BK;
    unsigned voffA[2], voffB[2];
#pragma unroll
    for (int i = 0; i < 2; ++i) { int R, C; stage_rc(tid * 16 + i * 8192, R, C); const int Rb = Epi::PERM ? ((R & ~31) + perm32(R & 31)) : R;
        voffA[i] = (unsigned)(R * K + C) * 2u; voffB[i] = (unsigned)(Rb * K + C) * 2u; }
    const size_t kstep = (size_t)(BK * 2);
    const size_t hstep = (size_t)HALF * K * 2;
    const size_t tstep = 2 * hstep;
    const unsigned ldsw = (unsigned)wid * 1024u;
    const int aoff = lds_byte(wr * 64 + fr, fq * 8), boff = lds_byte(wc * 32 + fr, fq * 8);
#define PG8_SA(b, h) (((b) * 2 + (h)) * HTB)
#define PG8_SB(b, h) ((4 + (b) * 2 + (h)) * HTB)
#define PG8_STAGE(bufoff, gbase, voff) do { _Pragma("unroll") for (int _i = 0; _i < 2; ++_i) \
        __builtin_amdgcn_global_load_lds((const unsigned*)((const char*)(gbase) + (voff)[_i]), (LAS unsigned*)(lds + (bufoff) + ldsw + _i * 8192), 16, 0, 0); } while (0)
#define PG8_LDA(dst, b, h) do { _Pragma("unroll") for (int m = 0; m < 4; ++m) _Pragma("unroll") for (int k = 0; k < 2; ++k) dst[m][k] = *(const LAS bf16x8*)(lds + PG8_SA(b, h) + aoff + m * 2048 + k * 1024); } while (0)
#define PG8_LDB(dst, b, h) do { _Pragma("unroll") for (int n = 0; n < 2; ++n) _Pragma("unroll") for (int k = 0; k < 2; ++k) dst[n][k] = *(const LAS bf16x8*)(lds + PG8_SB(b, h) + boff + n * 2048 + k * 1024); } while (0)
#define PG8_MMA(ai, bj, At, Bt) do { __builtin_amdgcn_s_setprio(1); _Pragma("unroll") for (int m = 0; m < 4; ++m) _Pragma("unroll") for (int n = 0; n < 2; ++n) _Pragma("unroll") for (int k = 0; k < 2; ++k) \
        acc[ai][bj][m][n] = __builtin_amdgcn_mfma_f32_16x16x32_bf16(Bt[n][k], At[m][k], acc[ai][bj][m][n], 0, 0, 0); __builtin_amdgcn_s_setprio(0); } while (0)
#define PG8_WAIT_V(n) asm volatile("s_waitcnt vmcnt(" #n ")" ::: "memory")
#define PG8_WAIT_L(n) asm volatile("s_waitcnt lgkmcnt(" #n ")" ::: "memory")
#define PG8_BAR __builtin_amdgcn_s_barrier()
#define PG8_SCHED __builtin_amdgcn_sched_barrier(0)
    Unit cur, nxt; int ui = 0;
    if (!S.next(0, cur)) return;
    f32x4 acc[2][2][4][2];
#pragma unroll
    for (int a = 0; a < 2; ++a)
#pragma unroll
        for (int b = 0; b < 2; ++b)
#pragma unroll
            for (int m = 0; m < 4; ++m)
#pragma unroll
                for (int n = 0; n < 2; ++n) acc[a][b][m][n] = (f32x4){0.f, 0.f, 0.f, 0.f};
    bf16x8 At[4][2], B0[2][2], B1[2][2];
    const char* cA = (const char*)g.A + (size_t)cur.pm * tstep; const char* cB = (const char*)g.Bt + (size_t)cur.pn * tstep;
    if constexpr (SP2) {
        PG8_STAGE(PG8_SB(0, 0), cB, voffB); PG8_STAGE(PG8_SB(0, 1), cB + hstep, voffB); PG8_STAGE(PG8_SA(0, 0), cA, voffA); PG8_STAGE(PG8_SA(0, 1), cA + hstep, voffA);
        if (wr == 1) PG8_BAR;
        PG8_WAIT_V(2); PG8_BAR;
        PG8_STAGE(PG8_SB(1, 0), cB + kstep, voffB); PG8_STAGE(PG8_SA(1, 0), cA + kstep, voffA); PG8_STAGE(PG8_SB(1, 1), cB + hstep + kstep, voffB);
        PG8_WAIT_V(6); PG8_BAR;
    } else {
        PG8_STAGE(PG8_SB(0, 0), cB, voffB); PG8_STAGE(PG8_SA(0, 0), cA, voffA); PG8_STAGE(PG8_SB(0, 1), cB + hstep, voffB); PG8_STAGE(PG8_SA(0, 1), cA + hstep, voffA);
        if (wr == 1) PG8_BAR;
        PG8_WAIT_V(4); PG8_BAR;
        PG8_STAGE(PG8_SB(1, 0), cB + kstep, voffB); PG8_STAGE(PG8_SA(1, 0), cA + kstep, voffA); PG8_STAGE(PG8_SB(1, 1), cB + hstep + kstep, voffB);
        PG8_WAIT_V(6); PG8_BAR;
    }
    for (;;) {
        const bool has_next = S.next(ui + 1, nxt);
        const char* nA = has_next ? (const char*)g.A + (size_t)nxt.pm * tstep : cA; const char* nB = has_next ? (const char*)g.Bt + (size_t)nxt.pn * tstep : cB;
        for (int t = 0; t < nt; t += 2) {
            const bool last = (t == nt - 2);
            const char* a1 = cA + (size_t)(t + 1) * kstep;
            const char* a2 = last ? nA : cA + (size_t)(t + 2) * kstep; const char* b2 = last ? nB : cB + (size_t)(t + 2) * kstep;
            const char* a3 = a2 + kstep; const char* b3 = b2 + kstep;
            if constexpr (SP2) {
            PG8_LDB(B0, 0, 0); PG8_LDB(B1, 0, 1); PG8_SCHED; PG8_LDA(At, 0, 0); PG8_STAGE(PG8_SA(1, 1), a1 + hstep, voffA);
            PG8_WAIT_V(8); PG8_WAIT_L(0); PG8_BAR; PG8_MMA(0, 0, At, B0); PG8_MMA(0, 1, At, B1); PG8_BAR; PG8_SCHED;
            PG8_LDA(At, 0, 1); PG8_STAGE(PG8_SB(0, 0), b2, voffB); PG8_STAGE(PG8_SB(0, 1), b2 + hstep, voffB); PG8_STAGE(PG8_SA(0, 0), a2, voffA);
            PG8_WAIT_V(8); PG8_WAIT_L(0); PG8_BAR; PG8_MMA(1, 0, At, B0); PG8_MMA(1, 1, At, B1); PG8_BAR; PG8_SCHED;
            PG8_LDB(B0, 1, 0); PG8_LDB(B1, 1, 1); PG8_SCHED; PG8_LDA(At, 1, 0); PG8_STAGE(PG8_SA(0, 1), a2 + hstep, voffA);
            PG8_WAIT_V(8); PG8_WAIT_L(0); PG8_BAR; PG8_MMA(0, 0, At, B0); PG8_MMA(0, 1, At, B1); PG8_BAR; PG8_SCHED;
            PG8_LDA(At, 1, 1); PG8_STAGE(PG8_SB(1, 0), b3, voffB); PG8_STAGE(PG8_SB(1, 1), b3 + hstep, voffB); PG8_STAGE(PG8_SA(1, 0), a3, voffA);
            PG8_WAIT_V(8); PG8_WAIT_L(0); PG8_BAR; PG8_MMA(1, 0, At, B0); PG8_MMA(1, 1, At, B1); PG8_BAR; PG8_SCHED;
            } else {
            PG8_LDB(B0, 0, 0); PG8_SCHED; PG8_LDA(At, 0, 0); PG8_STAGE(PG8_SA(1, 1), a1 + hstep, voffA);
            PG8_WAIT_L(8); PG8_BAR; PG8_WAIT_L(0); PG8_MMA(0, 0, At, B0); PG8_BAR; PG8_SCHED;
            PG8_LDB(B1, 0, 1); PG8_STAGE(PG8_SB(0, 0), b2, voffB);
            PG8_BAR; PG8_WAIT_L(0); PG8_MMA(0, 1, At, B1); PG8_BAR;
            PG8_LDA(At, 0, 1); PG8_STAGE(PG8_SA(0, 0), a2, voffA);
            PG8_BAR; PG8_WAIT_L(0); PG8_MMA(1, 0, At, B0); PG8_BAR; PG8_SCHED;
            PG8_STAGE(PG8_SB(0, 1), b2 + hstep, voffB);
            PG8_WAIT_V(6); PG8_BAR; PG8_MMA(1, 1, At, B1); PG8_BAR;
            PG8_LDB(B0, 1, 0); PG8_SCHED; PG8_LDA(At, 1, 0); PG8_STAGE(PG8_SA(0, 1), a2 + hstep, voffA);
            PG8_WAIT_L(8); PG8_BAR; PG8_WAIT_L(0); PG8_MMA(0, 0, At, B0); PG8_BAR; PG8_SCHED;
            PG8_LDB(B1, 1, 1); PG8_STAGE(PG8_SB(1, 0), b3, voffB);
            PG8_BAR; PG8_WAIT_L(0); PG8_MMA(0, 1, At, B1); PG8_BAR;
            PG8_LDA(At, 1, 1); PG8_STAGE(PG8_SA(1, 0), a3, voffA);
            PG8_BAR; PG8_WAIT_L(0); PG8_MMA(1, 0, At, B0); PG8_BAR; PG8_SCHED;
            PG8_STAGE(PG8_SB(1, 1), b3 + hstep, voffB);
            PG8_WAIT_V(6); PG8_BAR; PG8_MMA(1, 1, At, B1); PG8_BAR;
            }
        }
        if constexpr (ALIGN_EPI) { if (wr == 0) PG8_BAR; }
        E(acc, cur, wr, wc, fr, fq);
        if (!has_next) break;
#pragma unroll
        for (int a = 0; a < 2; ++a)
#pragma unroll
            for (int b = 0; b < 2; ++b)
#pragma unroll
                for (int m = 0; m < 4; ++m)
#pragma unroll
                    for (int n = 0; n < 2; ++n) acc[a][b][m][n] = (f32x4){0.f, 0.f, 0.f, 0.f};
        cur = nxt; cA = nA; cB = nB; ++ui;
        if constexpr (ALIGN_EPI) { if (wr == 1) PG8_BAR; }
    }
    PG8_WAIT_V(0);
    if constexpr (!ALIGN_EPI) { if (wr == 0) PG8_BAR; }
    PG8_BAR;
#undef PG8_SA
#undef PG8_SB
#undef PG8_STAGE
#undef PG8_LDA
#undef PG8_LDB
#undef PG8_MMA
#undef PG8_WAIT_V
#undef PG8_WAIT_L
#undef PG8_BAR
#undef PG8_SCHED
}
}

__device__ __forceinline__ void transpose_item(const float* W, int K, int N, bf16_t* WT, LAS float* scr, int item, int lane) {
    const int nblk = N / 32, kb = item / nblk, nb = item % nblk, k0 = 64 * kb, n0 = 32 * nb;
#pragma unroll 8
    for (int i = 0; i < 32; ++i) { const int kk = 2 * i + (lane >> 5); scr[kk * 33 + (lane & 31)] = W[(size_t)(k0 + kk) * N + n0 + (lane & 31)]; }
    asm volatile("s_waitcnt lgkmcnt(0)" ::: "memory");
    const int c = lane & 7;
#pragma unroll
    for (int j = 0; j < 4; ++j) { const int n = (lane >> 3) + 8 * j; const LAS float* s = scr + (8 * c) * 33 + n;
        u32x4 o; o.x = pk2(s[0 * 33], s[1 * 33]); o.y = pk2(s[2 * 33], s[3 * 33]); o.z = pk2(s[4 * 33], s[5 * 33]); o.w = pk2(s[6 * 33], s[7 * 33]);
        *(u32x4*)(WT + (size_t)(n0 + n) * K + k0 + 8 * c) = o; }
    asm volatile("s_waitcnt lgkmcnt(0)" ::: "memory");
}

__device__ __forceinline__ void mod_item(const Params& P, LAS unsigned char* lds, int item, int tid) {
    LAS float* cs = (LAS float*)lds;
    LAS float* red = (LAS float*)(lds + 65536);
    const int l = item / 96, nb = item % 96, wid = tid >> 6, lane = tid & 63;
    for (int i = tid; i < 16 * 1024; i += 512) { const float v = P.c[i]; cs[i] = v / (1.f + __expf(-v)); }
    __syncthreads();
    float acc[16];
#pragma unroll
    for (int b = 0; b < 16; ++b) acc[b] = 0.f;
    const float* wp = P.w_ada + (size_t)l * 1024 * 6144 + (size_t)(wid * 128) * 6144 + nb * 64 + lane;
#pragma unroll 4
    for (int k = 0; k < 128; ++k) { const float wv = wp[(size_t)k * 6144];
#pragma unroll
        for (int b = 0; b < 16; ++b) acc[b] += cs[b * 1024 + wid * 128 + k] * wv; }
#pragma unroll
    for (int b = 0; b < 16; ++b) red[(wid * 16 + b) * 64 + lane] = acc[b];
    __syncthreads();
    float* mod = (float*)(P.ws + WS_MOD);
    for (int o = tid; o < 1024; o += 512) { const int b = o >> 6, cidx = o & 63; float s = P.b_ada[l * 6144 + nb * 64 + cidx];
#pragma unroll
        for (int w = 0; w < 8; ++w) s += red[(w * 16 + b) * 64 + cidx];
        mod[((size_t)l * 16 + b) * 6144 + nb * 64 + cidx] = s; }
    __syncthreads();
}

template <int MODE>
__device__ __forceinline__ void row_pass(const float* xin, const bf16_t* y, float* xout, bf16_t* hn, const float* gate, const float* lng, const float* lnb,
                                         const float* sc, const float* sh, int gw, int ngw, int lane) {
    for (int m = gw; m < M; m += ngw) {
        const int b = m >> 12;
        const f32x4* xr = (const f32x4*)(xin + (size_t)m * DM) + lane;
        f32x4 v[4];
#pragma unroll
        for (int j = 0; j < 4; ++j) v[j] = xr[64 * j];
        if (MODE >= 1) {
            const u32x2* yr = (const u32x2*)(y + (size_t)m * DM) + lane;
            const f32x4* gr = (const f32x4*)(gate + (size_t)b * 6144) + lane;
            float s = 0.f;
#pragma unroll
            for (int j = 0; j < 4; ++j) { const u32x2 yy = yr[64 * j]; const f32x4 g = gr[64 * j];
                v[j].x = ALPHA * v[j].x + (1.f + g.x) * bf2f(yy.x & 0xffffu); v[j].y = ALPHA * v[j].y + (1.f + g.y) * bf2f(yy.x >> 16);
                v[j].z = ALPHA * v[j].z + (1.f + g.z) * bf2f(yy.y & 0xffffu); v[j].w = ALPHA * v[j].w + (1.f + g.w) * bf2f(yy.y >> 16);
                s += (v[j].x + v[j].y) + (v[j].z + v[j].w); }
            const float mean = wave_sum(s) * (1.f / DM); float s2 = 0.f;
#pragma unroll
            for (int j = 0; j < 4; ++j) { v[j] = v[j] - mean; s2 += (v[j].x * v[j].x + v[j].y * v[j].y) + (v[j].z * v[j].z + v[j].w * v[j].w); }
            const float rstd = 1.f / sqrtf(wave_sum(s2) * (1.f / DM) + LN_EPS);
            f32x4* xo = (f32x4*)(xout + (size_t)m * DM) + lane;
#pragma unroll
            for (int j = 0; j < 4; ++j) { const f32x4 gg = ((const f32x4*)lng)[lane + 64 * j], bb = ((const f32x4*)lnb)[lane + 64 * j]; v[j] = v[j] * rstd * gg + bb; xo[64 * j] = v[j]; }
        }
        if (MODE != 2) {
            float s = 0.f;
#pragma unroll
            for (int j = 0; j < 4; ++j) s += (v[j].x + v[j].y) + (v[j].z + v[j].w);
            const float mean = wave_sum(s) * (1.f / DM); float s2 = 0.f;
#pragma unroll
            for (int j = 0; j < 4; ++j) { v[j] = v[j] - mean; s2 += (v[j].x * v[j].x + v[j].y * v[j].y) + (v[j].z * v[j].z + v[j].w * v[j].w); }
            const float rstd = 1.f / sqrtf(wave_sum(s2) * (1.f / DM) + LN_EPS);
            const f32x4* scr = (const f32x4*)(sc + (size_t)b * 6144) + lane; const f32x4* shr = (const f32x4*)(sh + (size_t)b * 6144) + lane;
            u32x2* o8 = (u32x2*)(hn + (size_t)m * DM) + lane;
#pragma unroll
            for (int j = 0; j < 4; ++j) { const f32x4 a = scr[64 * j], d = shr[64 * j]; const f32x4 r = v[j] * rstd * (1.f + a) + d;
                u32x2 w; w.x = pk2(r.x, r.y); w.y = pk2(r.z, r.w); o8[64 * j] = w; }
        }
    }
}

template <int MODE  >
__device__ __forceinline__ void naive_attn_task(const Params& P, const bf16_t* PROJ, bf16_t* YC, int l, int tb, int h, int lane) {
    constexpr int NDV = (MODE == 1) ? 32 : 64, NCV = NDV / 8;
    const int t = (MODE == 1) ? tb * 32 + (lane >> 1) : tb * 64 + lane, dh = (MODE == 1) ? (lane & 1) : 0, s = t & 4095, bS = t & ~4095;
    int qcol, kcol, vcol, ocol; float scale;
    if (MODE == 0) { qcol = QA + h * 64; kcol = KA + (h / 3) * 64; vcol = VA + (h / 3) * 64; ocol = h * 64; scale = 0.125f; }
    else if (MODE == 1) { qcol = QB + h * 64; kcol = KB + h * 64; vcol = VB + h * 64 + dh * 32; ocol = 384 + h * 64 + dh * 32; scale = 0.17677669529663687f; }
    else { qcol = QC + h * 64; kcol = KC + h * 64; vcol = VC + h * 64; ocol = 640 + h * 64; scale = 0.125f; }
    float q[64];
    { const u32x4* qp = (const u32x4*)(PROJ + (size_t)t * INW + qcol);
#pragma unroll
      for (int c = 0; c < 8; ++c) { const u32x4 w = qp[c];
        q[8 * c + 0] = bf2f(w.x & 0xffffu) * scale; q[8 * c + 1] = bf2f(w.x >> 16) * scale; q[8 * c + 2] = bf2f(w.y & 0xffffu) * scale; q[8 * c + 3] = bf2f(w.y >> 16) * scale;
        q[8 * c + 4] = bf2f(w.z & 0xffffu) * scale; q[8 * c + 5] = bf2f(w.z >> 16) * scale; q[8 * c + 6] = bf2f(w.w & 0xffffu) * scale; q[8 * c + 7] = bf2f(w.w >> 16) * scale; } }
    float m1 = -INFINITY, l1 = 0.f, m2 = -INFINITY, l2 = 0.f;
    float o1[NDV], o2[NDV];
#pragma unroll
    for (int d = 0; d < NDV; ++d) { o1[d] = 0.f; o2[d] = 0.f; }
    if (MODE == 0) { m1 = P.sink[l * 6 + h]; l1 = 1.f; }
    int k_lo, k_hi; const int s0 = (MODE == 1) ? 0 : ((tb * 64) & 4095);
    const int r = s0 >> 6, rs = min(max(r - 4, 0), 56), cq = s & 63, cstart = min(max(cq - 8, 0), 48);
    if (MODE == 0) { k_lo = max(0, s0 - 128); k_hi = min(4095, s0 + 63 + 128); }
    else if (MODE == 1) { k_lo = 0; k_hi = 4095; }
    else { k_lo = rs * 64; k_hi = rs * 64 + 511; }
    const float* t5 = P.t5; const float* rpb = P.rpb + ((size_t)l * 6 + h) * 15 * 31;
    for (int key = k_lo; key <= k_hi; ++key) {
        const int ku = __builtin_amdgcn_readfirstlane(key);
        const u32x4* kp = (const u32x4*)(PROJ + (size_t)(bS + ku) * INW + kcol);
        float sa = 0.f, sb = 0.f;
#pragma unroll
        for (int c = 0; c < 8; ++c) { const u32x4 w = kp[c]; float acc = 0.f;
            acc += q[8 * c + 0] * bf2f(w.x & 0xffffu); acc += q[8 * c + 1] * bf2f(w.x >> 16); acc += q[8 * c + 2] * bf2f(w.y & 0xffffu); acc += q[8 * c + 3] * bf2f(w.y >> 16);
            acc += q[8 * c + 4] * bf2f(w.z & 0xffffu); acc += q[8 * c + 5] * bf2f(w.z >> 16); acc += q[8 * c + 6] * bf2f(w.w & 0xffffu); acc += q[8 * c + 7] * bf2f(w.w >> 16);
            if (MODE == 1 && c >= 4) sb += acc; else sa += acc; }
        bool valid = true; float bias;
        if (MODE == 0) { const int rel = ku - s; valid = (rel >= -128 && rel <= 128); bias = t5[t5_bucket(rel) * 10 + h]; }
        else if (MODE == 1) { bias = t5[t5_bucket(ku - s) * 10 + 6 + h]; }
        else { const int kr = ku >> 6, kc = ku & 63; valid = (kc >= cstart && kc < cstart + 16); const int dc = min(max(kc - cq + 15, 0), 30); bias = rpb[(kr - r + 7) * 31 + dc]; }
        float f1 = 1.f, p1 = 0.f, f2 = 1.f, p2 = 0.f;
        if (valid) {
            const float x1 = sa + bias;
            if (x1 > m1) { f1 = __expf(m1 - x1); m1 = x1; }
            p1 = __expf(x1 - m1);
            if (MODE == 1) { const float x2 = sb + bias; if (x2 > m2) { f2 = __expf(m2 - x2); m2 = x2; } p2 = __expf(x2 - m2); }
        }
        l1 = l1 * f1 + p1; if (MODE == 1) l2 = l2 * f2 + p2;
        { const u32x4* vp = (const u32x4*)(PROJ + (size_t)(bS + ku) * INW + vcol);
#pragma unroll
          for (int c = 0; c < NCV; ++c) { const u32x4 w = vp[c]; float v[8];
            v[0] = bf2f(w.x & 0xffffu); v[1] = bf2f(w.x >> 16); v[2] = bf2f(w.y & 0xffffu); v[3] = bf2f(w.y >> 16);
            v[4] = bf2f(w.z & 0xffffu); v[5] = bf2f(w.z >> 16); v[6] = bf2f(w.w & 0xffffu); v[7] = bf2f(w.w >> 16);
#pragma unroll
            for (int e = 0; e < 8; ++e) { o1[8 * c + e] = o1[8 * c + e] * f1 + p1 * v[e]; if (MODE == 1) o2[8 * c + e] = o2[8 * c + e] * f2 + p2 * v[e]; } } }
    }
    const float inv1 = 1.f / l1;
    if (MODE == 1) {
        const float lam = ((const float*)(P.ws + WS_LAM))[l], lam_init = ((const float*)(P.ws + WS_LAM))[4 + l];
        const float inv2 = lam / l2; float ss = 0.f;
#pragma unroll
        for (int d = 0; d < NDV; ++d) { o1[d] = o1[d] * inv1 - o2[d] * inv2; ss += o1[d] * o1[d]; }
        ss += __shfl_xor(ss, 1);
        const float rn = (1.f / sqrtf(ss * (1.f / 64.f) + LN_EPS)) * (1.f - lam_init);
#pragma unroll
        for (int d = 0; d < NDV; ++d) o1[d] = o1[d] * rn * P.subln[l * 64 + dh * 32 + d];
    } else {
#pragma unroll
        for (int d = 0; d < NDV; ++d) o1[d] *= inv1;
    }
    u32x4* op = (u32x4*)(YC + (size_t)t * DM + ocol);
#pragma unroll
    for (int c = 0; c < NCV; ++c) { u32x4 w; w.x = pk2(o1[8 * c], o1[8 * c + 1]); w.y = pk2(o1[8 * c + 2], o1[8 * c + 3]); w.z = pk2(o1[8 * c + 4], o1[8 * c + 5]); w.w = pk2(o1[8 * c + 6], o1[8 * c + 7]); op[c] = w; }
}

__global__ void __launch_bounds__(512, 2) fwd_megakernel(Params P) {
    extern __shared__ __attribute__((aligned(16))) unsigned char lds_raw[];
    LAS unsigned char* lds = (LAS unsigned char*)lds_raw;
    cg::grid_group grid = cg::this_grid();
    const int G = gridDim.x, bx = blockIdx.x, ngw = G * 8;
#define FRESH_IDS int tid = threadIdx.x; asm volatile("" : "+v"(tid)); const int lane = tid & 63, wid = __builtin_amdgcn_readfirstlane(tid >> 6), gw = bx * 8 + wid; (void)lane; (void)gw;
    unsigned char* ws = P.ws;
    float* mod = (float*)(ws + WS_MOD);
    bf16_t* HN = (bf16_t*)(ws + WS_HN); bf16_t* Y = (bf16_t*)(ws + WS_Y); bf16_t* PROJ = (bf16_t*)(ws + WS_R); bf16_t* YCAT = (bf16_t*)(ws + WS_YCAT); bf16_t* HID = (bf16_t*)(ws + WS_R);

    {
        FRESH_IDS
        LAS float* scr = (LAS float*)(lds + wid * 16384);
        constexpr int I_IN = 16 * 80, I_OUT = 16 * 32, I_1 = 16 * 128, I_2 = 64 * 32, I_L = I_IN + I_OUT + I_1 + I_2;
        for (int it = gw; it < DEPTH * I_L; it += ngw) {
            const int l = it / I_L; int r = it % I_L;
            if (r < I_IN) { transpose_item(P.w_in + (size_t)l * DM * INW, DM, INW, (bf16_t*)(ws + WS_WIN) + (size_t)l * INW * DM, scr, r, lane); continue; } r -= I_IN;
            if (r < I_OUT) { transpose_item(P.w_out + (size_t)l * DM * DM, DM, DM, (bf16_t*)(ws + WS_WOUT) + (size_t)l * DM * DM, scr, r, lane); continue; } r -= I_OUT;
            if (r < I_1) { transpose_item(P.w_ff1 + (size_t)l * DM * FF, DM, FF, (bf16_t*)(ws + WS_W1) + (size_t)l * FF * DM, scr, r, lane); continue; } r -= I_1;
            transpose_item(P.w_ff2 + (size_t)l * FF * DM, FF, DM, (bf16_t*)(ws + WS_W2) + (size_t)l * DM * FF, scr, r, lane);
        }
        __syncthreads();
        for (int it = bx; it < DEPTH * 96; it += G) mod_item(P, lds, it, tid);
        if (bx == 0 && tid < DEPTH) {
            const float* lv = P.dlam + tid * 128; float a = 0.f, b = 0.f;
            for (int i = 0; i < 32; ++i) { a += lv[i] * lv[32 + i]; b += lv[64 + i] * lv[96 + i]; }
            const float lam_init = 0.8f - 0.6f * expf(-0.3f * (float)tid);
            ((float*)(ws + WS_LAM))[tid] = expf(a) - expf(b) + lam_init; ((float*)(ws + WS_LAM))[4 + tid] = lam_init;
        }
    }
    grid.sync();
    { FRESH_IDS row_pass<0>(P.x, nullptr, nullptr, HN, nullptr, nullptr, nullptr, mod + 1024, mod, gw, ngw, lane); }
    grid.sync();

#pragma unroll
    for (int l = 0; l < DEPTH; ++l) {
        const float* modl = mod + (size_t)l * 16 * 6144;
        { pg8::Gemm g{HN, (const bf16_t*)(ws + WS_WIN) + (size_t)l * INW * DM, M, INW, DM}; pg8::StaticOrder S; S.init(M, INW, G, bx);
          pg8::EpiBf16<0> E{PROJ, INW}; pg8::gemm_phase<pg8::EpiBf16<0>, pg8::StaticOrder, true, true>(lds, g, S, E); }
        grid.sync();
        {
            FRESH_IDS
            for (int task = gw; task < 1024 * 12 + 2048 * 4; task += ngw) {
                if (task < 1024 * 12) { const int hh = task % 12, tb = task / 12;
                    if (hh < 6) naive_attn_task<0>(P, PROJ, YCAT, l, tb, hh, lane);
                    else naive_attn_task<2>(P, PROJ, YCAT, l, tb, hh - 6, lane);
                } else { const int t2 = task - 1024 * 12; naive_attn_task<1>(P, PROJ, YCAT, l, t2 >> 2, t2 & 3, lane); }
            }
        }
        grid.sync();
        { pg8::Gemm g{YCAT, (const bf16_t*)(ws + WS_WOUT) + (size_t)l * DM * DM, M, DM, DM}; pg8::StaticOrder S; S.init(M, DM, G, bx);
          pg8::EpiBf16<0> E{Y, DM}; pg8::gemm_phase<pg8::EpiBf16<0>, pg8::StaticOrder, true, true>(lds, g, S, E); }
        grid.sync();
        { FRESH_IDS row_pass<1>(l == 0 ? P.x : P.out, Y, P.out, HN, modl + 2048, P.ln_g + (size_t)(l * 2) * DM, P.ln_b + (size_t)(l * 2) * DM, modl + 4096, modl + 3072, gw, ngw, lane); }
        grid.sync();
        { pg8::Gemm g{HN, (const bf16_t*)(ws + WS_W1) + (size_t)l * FF * DM, M, FF, DM}; pg8::StaticOrder S; S.init(M, FF, G, bx);
          pg8::EpiBf16<2> E{HID, FF}; pg8::gemm_phase<pg8::EpiBf16<2>, pg8::StaticOrder, true, true>(lds, g, S, E); }
        grid.sync();
        { pg8::Gemm g{HID, (const bf16_t*)(ws + WS_W2) + (size_t)l * DM * FF, M, DM, FF}; pg8::StaticOrder S; S.init(M, DM, G, bx);
          pg8::EpiBf16<0> E{Y, DM}; pg8::gemm_phase<pg8::EpiBf16<0>, pg8::StaticOrder, true, true>(lds, g, S, E); }
        grid.sync();
        if (l + 1 < DEPTH) {
            const float* modn = modl + 16 * 6144;
            FRESH_IDS row_pass<1>(P.out, Y, P.out, HN, modl + 5120, P.ln_g + (size_t)(l * 2 + 1) * DM, P.ln_b + (size_t)(l * 2 + 1) * DM, modn + 1024, modn, gw, ngw, lane);
            grid.sync();
        } else {
            FRESH_IDS row_pass<2>(P.out, Y, P.out, nullptr, modl + 5120, P.ln_g + (size_t)(l * 2 + 1) * DM, P.ln_b + (size_t)(l * 2 + 1) * DM, nullptr, nullptr, gw, ngw, lane);
        }
    }
}

extern "C" void kernel_launch(void* const* d_in, const int* in_sizes, int n_in, void* d_out, int out_size, void* d_ws, size_t ws_size, hipStream_t stream) {
    static int grid = 0;
    if (grid == 0) {
        if (n_in != 15 || in_sizes[0] != M * DM || out_size != M * DM || ws_size < WS_END) { fprintf(stderr, "kernel_launch: unexpected shapes (n_in %d in0 %d out %d ws %zu)\n", n_in, n_in > 0 ? in_sizes[0] : -1, out_size, ws_size); grid = -1; return; }
        int dev = 0, cus = 0, per_cu = 0;
        hipGetDevice(&dev);
        hipDeviceGetAttribute(&cus, hipDeviceAttributeMultiprocessorCount, dev);
        if (hipFuncSetAttribute((const void*)fwd_megakernel, hipFuncAttributeMaxDynamicSharedMemorySize, LDS_BYTES) != hipSuccess) { fprintf(stderr, "kernel_launch: hipFuncSetAttribute failed\n"); grid = -1; return; }
        if (hipOccupancyMaxActiveBlocksPerMultiprocessor(&per_cu, (const void*)fwd_megakernel, 512, LDS_BYTES) != hipSuccess || per_cu < 1) { fprintf(stderr, "kernel_launch: occupancy query says %d\n", per_cu); per_cu = 1; }
        (void)hipGetLastError();
        grid = cus * 1;
    }
    if (grid < 0) return;
    Params p{};
    p.x = (const float*)d_in[0]; p.c = (const float*)d_in[1]; p.w_ada = (const float*)d_in[2]; p.b_ada = (const float*)d_in[3]; p.w_in = (const float*)d_in[4];
    p.w_out = (const float*)d_in[5]; p.t5 = (const float*)d_in[6]; p.sink = (const float*)d_in[7]; p.dlam = (const float*)d_in[8]; p.subln = (const float*)d_in[9];
    p.rpb = (const float*)d_in[10]; p.ln_g = (const float*)d_in[11]; p.ln_b = (const float*)d_in[12]; p.w_ff1 = (const float*)d_in[13]; p.w_ff2 = (const float*)d_in[14];
    p.out = (float*)d_out; p.ws = (unsigned char*)d_ws;
    void* args[] = {&p};
    hipError_t e = hipLaunchCooperativeKernel((const void*)fwd_megakernel, dim3(grid), dim3(512), args, LDS_BYTES, stream);
    if (e != hipSuccess) fprintf(stderr, "cooperative launch failed: %s (grid %d)\n", hipGetErrorString(e), grid);
}
```

```cpp
#include <hip/hip_runtime.h>
#include <hip/hip_cooperative_groups.h>
#include <cstdio>
#include <cstdint>
namespace cg = cooperative_groups;
#ifndef FAST_A
#define FAST_A 1
#endif
#ifndef FAST_B
#define FAST_B 1
#endif
#ifndef FAST_C
#define FAST_C 1
#endif

#define LAS __attribute__((address_space(3)))
typedef unsigned short bf16_t;
typedef short bf16x8 __attribute__((ext_vector_type(8)));
typedef float f32x4 __attribute__((ext_vector_type(4)));
typedef float f32x16 __attribute__((ext_vector_type(16)));
typedef unsigned u32x4 __attribute__((ext_vector_type(4)));
typedef unsigned u32x2 __attribute__((ext_vector_type(2)));

constexpr int BATCH = 16, SEQ = 4096, DM = 1024, DEPTH = 4, FF = 4096, INW = 2560;
constexpr int M = BATCH * SEQ;
constexpr float LN_EPS = 1e-5f;
constexpr float ALPHA = 1.681792830507429f;
constexpr int QA = 0, KA = 384, VA = 512, QB = 640, KB = 896, VB = 1152, QC = 1408, KC = 1792, VC = 2176;
constexpr size_t MiB = 1u << 20;
constexpr size_t WS_MOD = 0;
constexpr size_t WS_LAM = WS_MOD + 1792 * 1024;
constexpr size_t WS_WIN = 2 * MiB;
constexpr size_t WS_WOUT = 22 * MiB;
constexpr size_t WS_W1 = 30 * MiB;
constexpr size_t WS_W2 = 62 * MiB;
constexpr size_t WS_HN = 96 * MiB;
constexpr size_t WS_Y = 224 * MiB;
constexpr size_t WS_R = 352 * MiB;
constexpr size_t WS_YCAT = WS_R + 320 * MiB;
constexpr size_t WS_END = WS_R + 512 * MiB;

constexpr int LDS_BYTES = 147456;

struct Params {
    const float *x, *c, *w_ada, *b_ada, *w_in, *w_out, *t5, *sink, *dlam, *subln, *rpb, *ln_g, *ln_b, *w_ff1, *w_ff2;
    float* out; unsigned char* ws;
};

__device__ __forceinline__ float bf2f(unsigned v) { return __uint_as_float(v << 16); }
__device__ __forceinline__ unsigned f2bf(float f) { unsigned u = __float_as_uint(f); return (u + 0x7fffu + ((u >> 16) & 1u)) >> 16; }
__device__ __forceinline__ unsigned pk2(float lo, float hi) { return f2bf(lo) | (f2bf(hi) << 16); }
__device__ __forceinline__ float wave_sum(float v) {
#pragma unroll
    for (int o = 1; o < 64; o <<= 1) v += __shfl_xor(v, o);
    return v;
}
__device__ __forceinline__ int t5_bucket(int rel) {
    const int n = rel < 0 ? -rel : rel;
    int b;
    if (n < 8) b = n;
    else b = 8 + (n >= 12) + (n >= 16) + (n >= 23) + (n >= 32) + (n >= 46) + (n >= 64) + (n >= 91);
    return b + (rel > 0 ? 16 : 0);
}

namespace pg8 {
constexpr int BM = 256, BK = 64, HALF = 128, HTB = HALF * BK * 2, STAGE_BYTES = 8 * HTB, NXCD = 8, WGM = 8;
__host__ __device__ __forceinline__ int lds_byte(int r, int c) { const int st = (r >> 4) * 2 + (c >> 5), rr = r & 15, cc = c & 31, ob = rr * 64 + cc * 2; return st * 1024 + (ob ^ (((ob >> 9) & 1) << 5)); }
__host__ __device__ __forceinline__ void stage_rc(int b, int& R, int& C) { const int st = b / 1024, sb = b % 1024, swz = sb ^ (((sb >> 9) & 1) << 5); R = (st >> 1) * 16 + swz / 64; C = (st & 1) * 32 + (swz % 64) / 2; }
__host__ __device__ __forceinline__ int perm32(int rho) { const int n = rho >> 4, i = rho & 15; return 8 * (i >> 2) + 4 * n + (i & 3); }

struct Unit { int pm, pn; };
struct Gemm { const bf16_t* A; const bf16_t* Bt; int M, N, K; };

struct StaticOrder {
    int nM, nN, nwg, G, c;
    __device__ void init(int M_, int N_, int G_, int c_) { nM = M_ / BM; nN = N_ / BM; nwg = nM * nN; G = G_; c = c_; }
    __device__ bool next(int i, Unit& u) const {
        const long L = (long)i * G + c; if (L >= nwg) return false;
        int wgid = (int)L; { const int q = nwg / NXCD, r = nwg % NXCD, xcd = wgid % NXCD, off = wgid / NXCD; wgid = (xcd < r ? xcd * (q + 1) : r * (q + 1) + (xcd - r) * q) + off; }
        const int nig = WGM * nN, gid = wgid / nig, fm = gid * WGM, gsz = (nM - fm) < WGM ? (nM - fm) : WGM;
        u.pm = fm + ((wgid % nig) % gsz); u.pn = (wgid % nig) / gsz; return true;
    }
};

__device__ __forceinline__ unsigned cvt_pk_bf16(float lo, float hi) { unsigned r; asm volatile("v_cvt_pk_bf16_f32 %0, %1, %2" : "=v"(r) : "v"(lo), "v"(hi)); return r; }

template <int ACT  > struct EpiBf16 {
    static constexpr bool PERM = true, AFTER_DRAIN = false;
    bf16_t* O; int ldc;
    __device__ __forceinline__ void operator()(const f32x4 (&acc)[2][2][4][2], const Unit& u, int wr, int wc, int fr, int fq) const {
        const int row0 = u.pm * BM + wr * 64 + fr; const int col0 = u.pn * BM + wc * 32 + 8 * fq;
#pragma unroll
        for (int ai = 0; ai < 2; ++ai)
#pragma unroll
            for (int m = 0; m < 4; ++m) { bf16_t* rowp = O + (size_t)(row0 + ai * HALF + m * 16) * ldc + col0;
#pragma unroll
                for (int bj = 0; bj < 2; ++bj) { f32x4 v0 = acc[ai][bj][m][0], v1 = acc[ai][bj][m][1];
                    if (ACT == 2) {
#pragma unroll
                        for (int e = 0; e < 4; ++e) { const float a = fmaxf(v0[e], 0.f), b = fmaxf(v1[e], 0.f); v0[e] = a * a; v1[e] = b * b; } }
                    u32x4 w; w.x = cvt_pk_bf16(v0[0], v0[1]); w.y = cvt_pk_bf16(v0[2], v0[3]); w.z = cvt_pk_bf16(v1[0], v1[1]); w.w = cvt_pk_bf16(v1[2], v1[3]);
                    *(u32x4*)(rowp + bj * HALF) = w; } }
    }
};

template <class Epi, class Sched, bool ALIGN_EPI = false, bool SP2 = false>
__device__ __forceinline__ void gemm_phase(LAS unsigned char* lds, const Gemm g, const Sched& S, const Epi& E) {
    int tid = threadIdx.x; asm volatile("" : "+v"(tid));
    const int wid = __builtin_amdgcn_readfirstlane(tid >> 6), lane = tid & 63, wr = wid >> 2, wc = wid & 3, fr = lane & 15, fq = lane >> 4;
    const int K = g.K, nt = K / BK;
    unsigned voffA[2], voffB[2];
#pragma unroll
    for (int i = 0; i < 2; ++i) { int R, C; stage_rc(tid * 16 + i * 8192, R, C); const int Rb = Epi::PERM ? ((R & ~31) + perm32(R & 31)) : R;
        voffA[i] = (unsigned)(R * K + C) * 2u; voffB[i] = (unsigned)(Rb * K + C) * 2u; }
    const size_t kstep = (size_t)(BK * 2);
    const size_t hstep = (size_t)HALF * K * 2;
    const size_t tstep = 2 * hstep;
    const unsigned ldsw = (unsigned)wid * 1024u;
    const int aoff = lds_byte(wr * 64 + fr, fq * 8), boff = lds_byte(wc * 32 + fr, fq * 8);
#define PG8_SA(b, h) (((b) * 2 + (h)) * HTB)
#define PG8_SB(b, h) ((4 + (b) * 2 + (h)) * HTB)
#define PG8_STAGE(bufoff, gbase, voff) do { _Pragma("unroll") for (int _i = 0; _i < 2; ++_i) \
        __builtin_amdgcn_global_load_lds((const unsigned*)((const char*)(gbase) + (voff)[_i]), (LAS unsigned*)(lds + (bufoff) + ldsw + _i * 8192), 16, 0, 0); } while (0)
#define PG8_LDA(dst, b, h) do { _Pragma("unroll") for (int m = 0; m < 4; ++m) _Pragma("unroll") for (int k = 0; k < 2; ++k) dst[m][k] = *(const LAS bf16x8*)(lds + PG8_SA(b, h) + aoff + m * 2048 + k * 1024); } while (0)
#define PG8_LDB(dst, b, h) do { _Pragma("unroll") for (int n = 0; n < 2; ++n) _Pragma("unroll") for (int k = 0; k < 2; ++k) dst[n][k] = *(const LAS bf16x8*)(lds + PG8_SB(b, h) + boff + n * 2048 + k * 1024); } while (0)
#define PG8_MMA(ai, bj, At, Bt) do { __builtin_amdgcn_s_setprio(1); _Pragma("unroll") for (int m = 0; m < 4; ++m) _Pragma("unroll") for (int n = 0; n < 2; ++n) _Pragma("unroll") for (int k = 0; k < 2; ++k) \
        acc[ai][bj][m][n] = __builtin_amdgcn_mfma_f32_16x16x32_bf16(Bt[n][k], At[m][k], acc[ai][bj][m][n], 0, 0, 0); __builtin_amdgcn_s_setprio(0); } while (0)
#define PG8_WAIT_V(n) asm volatile("s_waitcnt vmcnt(" #n ")" ::: "memory")
#define PG8_WAIT_L(n) asm volatile("s_waitcnt lgkmcnt(" #n ")" ::: "memory")
#define PG8_BAR __builtin_amdgcn_s_barrier()
#define PG8_SCHED __builtin_amdgcn_sched_barrier(0)
    Unit cur, nxt; int ui = 0;
    if (!S.next(0, cur)) return;
    f32x4 acc[2][2][4][2];
#pragma unroll
    for (int a = 0; a < 2; ++a)
#pragma unroll
        for (int b = 0; b < 2; ++b)
#pragma unroll
            for (int m = 0; m < 4; ++m)
#pragma unroll
                for (int n = 0; n < 2; ++n) acc[a][b][m][n] = (f32x4){0.f, 0.f, 0.f, 0.f};
    bf16x8 At[4][2], B0[2][2], B1[2][2];
    const char* cA = (const char*)g.A + (size_t)cur.pm * tstep; const char* cB = (const char*)g.Bt + (size_t)cur.pn * tstep;
    if constexpr (SP2) {
        PG8_STAGE(PG8_SB(0, 0), cB, voffB); PG8_STAGE(PG8_SB(0, 1), cB + hstep, voffB); PG8_STAGE(PG8_SA(0, 0), cA, voffA); PG8_STAGE(PG8_SA(0, 1), cA + hstep, voffA);
        if (wr == 1) PG8_BAR;
        PG8_WAIT_V(2); PG8_BAR;
        PG8_STAGE(PG8_SB(1, 0), cB + kstep, voffB); PG8_STAGE(PG8_SA(1, 0), cA + kstep, voffA); PG8_STAGE(PG8_SB(1, 1), cB + hstep + kstep, voffB);
        PG8_WAIT_V(6); PG8_BAR;
    } else {
        PG8_STAGE(PG8_SB(0, 0), cB, voffB); PG8_STAGE(PG8_SA(0, 0), cA, voffA); PG8_STAGE(PG8_SB(0, 1), cB + hstep, voffB); PG8_STAGE(PG8_SA(0, 1), cA + hstep, voffA);
        if (wr == 1) PG8_BAR;
        PG8_WAIT_V(4); PG8_BAR;
        PG8_STAGE(PG8_SB(1, 0), cB + kstep, voffB); PG8_STAGE(PG8_SA(1, 0), cA + kstep, voffA); PG8_STAGE(PG8_SB(1, 1), cB + hstep + kstep, voffB);
        PG8_WAIT_V(6); PG8_BAR;
    }
    for (;;) {
        const bool has_next = S.next(ui + 1, nxt);
        const char* nA = has_next ? (const char*)g.A + (size_t)nxt.pm * tstep : cA; const char* nB = has_next ? (const char*)g.Bt + (size_t)nxt.pn * tstep : cB;
        for (int t = 0; t < nt; t += 2) {
            const bool last = (t == nt - 2);
            const char* a1 = cA + (size_t)(t + 1) * kstep;
            const char* a2 = last ? nA : cA + (size_t)(t + 2) * kstep; const char* b2 = last ? nB : cB + (size_t)(t + 2) * kstep;
            const char* a3 = a2 + kstep; const char* b3 = b2 + kstep;
            if constexpr (SP2) {
            PG8_LDB(B0, 0, 0); PG8_LDB(B1, 0, 1); PG8_SCHED; PG8_LDA(At, 0, 0); PG8_STAGE(PG8_SA(1, 1), a1 + hstep, voffA);
            PG8_WAIT_V(8); PG8_WAIT_L(0); PG8_BAR; PG8_MMA(0, 0, At, B0); PG8_MMA(0, 1, At, B1); PG8_BAR; PG8_SCHED;
            PG8_LDA(At, 0, 1); PG8_STAGE(PG8_SB(0, 0), b2, voffB); PG8_STAGE(PG8_SB(0, 1), b2 + hstep, voffB); PG8_STAGE(PG8_SA(0, 0), a2, voffA);
            PG8_WAIT_V(8); PG8_WAIT_L(0); PG8_BAR; PG8_MMA(1, 0, At, B0); PG8_MMA(1, 1, At, B1); PG8_BAR; PG8_SCHED;
            PG8_LDB(B0, 1, 0); PG8_LDB(B1, 1, 1); PG8_SCHED; PG8_LDA(At, 1, 0); PG8_STAGE(PG8_SA(0, 1), a2 + hstep, voffA);
            PG8_WAIT_V(8); PG8_WAIT_L(0); PG8_BAR; PG8_MMA(0, 0, At, B0); PG8_MMA(0, 1, At, B1); PG8_BAR; PG8_SCHED;
            PG8_LDA(At, 1, 1); PG8_STAGE(PG8_SB(1, 0), b3, voffB); PG8_STAGE(PG8_SB(1, 1), b3 + hstep, voffB); PG8_STAGE(PG8_SA(1, 0), a3, voffA);
            PG8_WAIT_V(8); PG8_WAIT_L(0); PG8_BAR; PG8_MMA(1, 0, At, B0); PG8_MMA(1, 1, At, B1); PG8_BAR; PG8_SCHED;
            } else {
            PG8_LDB(B0, 0, 0); PG8_SCHED; PG8_LDA(At, 0, 0); PG8_STAGE(PG8_SA(1, 1), a1 + hstep, voffA);
            PG8_WAIT_L(8); PG8_BAR; PG8_WAIT_L(0); PG8_MMA(0, 0, At, B0); PG8_BAR; PG8_SCHED;
            PG8_LDB(B1, 0, 1); PG8_STAGE(PG8_SB(0, 0), b2, voffB);
            PG8_BAR; PG8_WAIT_L(0); PG8_MMA(0, 1, At, B1); PG8_BAR;
            PG8_LDA(At, 0, 1); PG8_STAGE(PG8_SA(0, 0), a2, voffA);
            PG8_BAR; PG8_WAIT_L(0); PG8_MMA(1, 0, At, B0); PG8_BAR; PG8_SCHED;
            PG8_STAGE(PG8_SB(0, 1), b2 + hstep, voffB);
            PG8_WAIT_V(6); PG8_BAR; PG8_MMA(1, 1, At, B1); PG8_BAR;
            PG8_LDB(B0, 1, 0); PG8_SCHED; PG8_LDA(At, 1, 0); PG8_STAGE(PG8_SA(0, 1), a2 + hstep, voffA);
            PG8_WAIT_L(8); PG8_BAR; PG8_WAIT_L(0); PG8_MMA(0, 0, At, B0); PG8_BAR; PG8_SCHED;
            PG8_LDB(B1, 1, 1); PG8_STAGE(PG8_SB(1, 0), b3, voffB);
            PG8_BAR; PG8_WAIT_L(0); PG8_MMA(0, 1, At, B1); PG8_BAR;
            PG8_LDA(At, 1, 1); PG8_STAGE(PG8_SA(1, 0), a3, voffA);
            PG8_BAR; PG8_WAIT_L(0); PG8_MMA(1, 0, At, B0); PG8_BAR; PG8_SCHED;
            PG8_STAGE(PG8_SB(1, 1), b3 + hstep, voffB);
            PG8_WAIT_V(6); PG8_BAR; PG8_MMA(1, 1, At, B1); PG8_BAR;
            }
        }
        if constexpr (ALIGN_EPI) { if (wr == 0) PG8_BAR; }
        E(acc, cur, wr, wc, fr, fq);
        if (!has_next) break;
#pragma unroll
        for (int a = 0; a < 2; ++a)
#pragma unroll
            for (int b = 0; b < 2; ++b)
#pragma unroll
                for (int m = 0; m < 4; ++m)
#pragma unroll
                    for (int n = 0; n < 2; ++n) acc[a][b][m][n] = (f32x4){0.f, 0.f, 0.f, 0.f};
        cur = nxt; cA = nA; cB = nB; ++ui;
        if constexpr (ALIGN_EPI) { if (wr == 1) PG8_BAR; }
    }
    PG8_WAIT_V(0);
    if constexpr (!ALIGN_EPI) { if (wr == 0) PG8_BAR; }
    PG8_BAR;
#undef PG8_SA
#undef PG8_SB
#undef PG8_STAGE
#undef PG8_LDA
#undef PG8_LDB
#undef PG8_MMA
#undef PG8_WAIT_V
#undef PG8_WAIT_L
#undef PG8_BAR
#undef PG8_SCHED
}
}

__device__ __forceinline__ void transpose_item(const float* W, int K, int N, bf16_t* WT, LAS float* scr, int item, int lane) {
    const int nblk = N / 32, kb = item / nblk, nb = item % nblk, k0 = 64 * kb, n0 = 32 * nb;
#pragma unroll 8
    for (int i = 0; i < 32; ++i) { const int kk = 2 * i + (lane >> 5); scr[kk * 33 + (lane & 31)] = W[(size_t)(k0 + kk) * N + n0 + (lane & 31)]; }
    asm volatile("s_waitcnt lgkmcnt(0)" ::: "memory");
    const int c = lane & 7;
#pragma unroll
    for (int j = 0; j < 4; ++j) { const int n = (lane >> 3) + 8 * j; const LAS float* s = scr + (8 * c) * 33 + n;
        u32x4 o; o.x = pk2(s[0 * 33], s[1 * 33]); o.y = pk2(s[2 * 33], s[3 * 33]); o.z = pk2(s[4 * 33], s[5 * 33]); o.w = pk2(s[6 * 33], s[7 * 33]);
        *(u32x4*)(WT + (size_t)(n0 + n) * K + k0 + 8 * c) = o; }
    asm volatile("s_waitcnt lgkmcnt(0)" ::: "memory");
}

__device__ __forceinline__ void mod_item(const Params& P, LAS unsigned char* lds, int item, int tid) {
    LAS float* cs = (LAS float*)lds;
    LAS float* red = (LAS float*)(lds + 65536);
    const int l = item / 96, nb = item % 96, wid = tid >> 6, lane = tid & 63;
    for (int i = tid; i < 16 * 1024; i += 512) { const float v = P.c[i]; cs[i] = v / (1.f + __expf(-v)); }
    __syncthreads();
    float acc[16];
#pragma unroll
    for (int b = 0; b < 16; ++b) acc[b] = 0.f;
    const float* wp = P.w_ada + (size_t)l * 1024 * 6144 + (size_t)(wid * 128) * 6144 + nb * 64 + lane;
#pragma unroll 4
    for (int k = 0; k < 128; ++k) { const float wv = wp[(size_t)k * 6144];
#pragma unroll
        for (int b = 0; b < 16; ++b) acc[b] += cs[b * 1024 + wid * 128 + k] * wv; }
#pragma unroll
    for (int b = 0; b < 16; ++b) red[(wid * 16 + b) * 64 + lane] = acc[b];
    __syncthreads();
    float* mod = (float*)(P.ws + WS_MOD);
    for (int o = tid; o < 1024; o += 512) { const int b = o >> 6, cidx = o & 63; float s = P.b_ada[l * 6144 + nb * 64 + cidx];
#pragma unroll
        for (int w = 0; w < 8; ++w) s += red[(w * 16 + b) * 64 + cidx];
        mod[((size_t)l * 16 + b) * 6144 + nb * 64 + cidx] = s; }
    __syncthreads();
}

template <int MODE>
__device__ __forceinline__ void row_pass(const float* xin, const bf16_t* y, float* xout, bf16_t* hn, const float* gate, const float* lng, const float* lnb,
                                         const float* sc, const float* sh, int gw, int ngw, int lane) {
    for (int m = gw; m < M; m += ngw) {
        const int b = m >> 12;
        const f32x4* xr = (const f32x4*)(xin + (size_t)m * DM) + lane;
        f32x4 v[4];
#pragma unroll
        for (int j = 0; j < 4; ++j) v[j] = xr[64 * j];
        if (MODE >= 1) {
            const u32x2* yr = (const u32x2*)(y + (size_t)m * DM) + lane;
            const f32x4* gr = (const f32x4*)(gate + (size_t)b * 6144) + lane;
            float s = 0.f;
#pragma unroll
            for (int j = 0; j < 4; ++j) { const u32x2 yy = yr[64 * j]; const f32x4 g = gr[64 * j];
                v[j].x = ALPHA * v[j].x + (1.f + g.x) * bf2f(yy.x & 0xffffu); v[j].y = ALPHA * v[j].y + (1.f + g.y) * bf2f(yy.x >> 16);
                v[j].z = ALPHA * v[j].z + (1.f + g.z) * bf2f(yy.y & 0xffffu); v[j].w = ALPHA * v[j].w + (1.f + g.w) * bf2f(yy.y >> 16);
                s += (v[j].x + v[j].y) + (v[j].z + v[j].w); }
            const float mean = wave_sum(s) * (1.f / DM); float s2 = 0.f;
#pragma unroll
            for (int j = 0; j < 4; ++j) { v[j] = v[j] - mean; s2 += (v[j].x * v[j].x + v[j].y * v[j].y) + (v[j].z * v[j].z + v[j].w * v[j].w); }
            const float rstd = 1.f / sqrtf(wave_sum(s2) * (1.f / DM) + LN_EPS);
            f32x4* xo = (f32x4*)(xout + (size_t)m * DM) + lane;
#pragma unroll
            for (int j = 0; j < 4; ++j) { const f32x4 gg = ((const f32x4*)lng)[lane + 64 * j], bb = ((const f32x4*)lnb)[lane + 64 * j]; v[j] = v[j] * rstd * gg + bb; xo[64 * j] = v[j]; }
        }
        if (MODE != 2) {
            float s = 0.f;
#pragma unroll
            for (int j = 0; j < 4; ++j) s += (v[j].x + v[j].y) + (v[j].z + v[j].w);
            const float mean = wave_sum(s) * (1.f / DM); float s2 = 0.f;
#pragma unroll
            for (int j = 0; j < 4; ++j) { v[j] = v[j] - mean; s2 += (v[j].x * v[j].x + v[j].y * v[j].y) + (v[j].z * v[j].z + v[j].w * v[j].w); }
            const float rstd = 1.f / sqrtf(wave_sum(s2) * (1.f / DM) + LN_EPS);
            const f32x4* scr = (const f32x4*)(sc + (size_t)b * 6144) + lane; const f32x4* shr = (const f32x4*)(sh + (size_t)b * 6144) + lane;
            u32x2* o8 = (u32x2*)(hn + (size_t)m * DM) + lane;
#pragma unroll
            for (int j = 0; j < 4; ++j) { const f32x4 a = scr[64 * j], d = shr[64 * j]; const f32x4 r = v[j] * rstd * (1.f + a) + d;
                u32x2 w; w.x = pk2(r.x, r.y); w.y = pk2(r.z, r.w); o8[64 * j] = w; }
        }
    }
}

template <int MODE  >
__device__ __forceinline__ void naive_attn_task(const Params& P, const bf16_t* PROJ, bf16_t* YC, int l, int tb, int h, int lane) {
    constexpr int NDV = (MODE == 1) ? 32 : 64, NCV = NDV / 8;
    const int t = (MODE == 1) ? tb * 32 + (lane >> 1) : tb * 64 + lane, dh = (MODE == 1) ? (lane & 1) : 0, s = t & 4095, bS = t & ~4095;
    int qcol, kcol, vcol, ocol; float scale;
    if (MODE == 0) { qcol = QA + h * 64; kcol = KA + (h / 3) * 64; vcol = VA + (h / 3) * 64; ocol = h * 64; scale = 0.125f; }
    else if (MODE == 1) { qcol = QB + h * 64; kcol = KB + h * 64; vcol = VB + h * 64 + dh * 32; ocol = 384 + h * 64 + dh * 32; scale = 0.17677669529663687f; }
    else { qcol = QC + h * 64; kcol = KC + h * 64; vcol = VC + h * 64; ocol = 640 + h * 64; scale = 0.125f; }
    float q[64];
    { const u32x4* qp = (const u32x4*)(PROJ + (size_t)t * INW + qcol);
#pragma unroll
      for (int c = 0; c < 8; ++c) { const u32x4 w = qp[c];
        q[8 * c + 0] = bf2f(w.x & 0xffffu) * scale; q[8 * c + 1] = bf2f(w.x >> 16) * scale; q[8 * c + 2] = bf2f(w.y & 0xffffu) * scale; q[8 * c + 3] = bf2f(w.y >> 16) * scale;
        q[8 * c + 4] = bf2f(w.z & 0xffffu) * scale; q[8 * c + 5] = bf2f(w.z >> 16) * scale; q[8 * c + 6] = bf2f(w.w & 0xffffu) * scale; q[8 * c + 7] = bf2f(w.w >> 16) * scale; } }
    float m1 = -INFINITY, l1 = 0.f, m2 = -INFINITY, l2 = 0.f;
    float o1[NDV], o2[NDV];
#pragma unroll
    for (int d = 0; d < NDV; ++d) { o1[d] = 0.f; o2[d] = 0.f; }
    if (MODE == 0) { m1 = P.sink[l * 6 + h]; l1 = 1.f; }
    int k_lo, k_hi; const int s0 = (MODE == 1) ? 0 : ((tb * 64) & 4095);
    const int r = s0 >> 6, rs = min(max(r - 4, 0), 56), cq = s & 63, cstart = min(max(cq - 8, 0), 48);
    if (MODE == 0) { k_lo = max(0, s0 - 128); k_hi = min(4095, s0 + 63 + 128); }
    else if (MODE == 1) { k_lo = 0; k_hi = 4095; }
    else { k_lo = rs * 64; k_hi = rs * 64 + 511; }
    const float* t5 = P.t5; const float* rpb = P.rpb + ((size_t)l * 6 + h) * 15 * 31;
    for (int key = k_lo; key <= k_hi; ++key) {
        const int ku = __builtin_amdgcn_readfirstlane(key);
        const u32x4* kp = (const u32x4*)(PROJ + (size_t)(bS + ku) * INW + kcol);
        float sa = 0.f, sb = 0.f;
#pragma unroll
        for (int c = 0; c < 8; ++c) { const u32x4 w = kp[c]; float acc = 0.f;
            acc += q[8 * c + 0] * bf2f(w.x & 0xffffu); acc += q[8 * c + 1] * bf2f(w.x >> 16); acc += q[8 * c + 2] * bf2f(w.y & 0xffffu); acc += q[8 * c + 3] * bf2f(w.y >> 16);
            acc += q[8 * c + 4] * bf2f(w.z & 0xffffu); acc += q[8 * c + 5] * bf2f(w.z >> 16); acc += q[8 * c + 6] * bf2f(w.w & 0xffffu); acc += q[8 * c + 7] * bf2f(w.w >> 16);
            if (MODE == 1 && c >= 4) sb += acc; else sa += acc; }
        bool valid = true; float bias;
        if (MODE == 0) { const int rel = ku - s; valid = (rel >= -128 && rel <= 128); bias = t5[t5_bucket(rel) * 10 + h]; }
        else if (MODE == 1) { bias = t5[t5_bucket(ku - s) * 10 + 6 + h]; }
        else { const int kr = ku >> 6, kc = ku & 63; valid = (kc >= cstart && kc < cstart + 16); const int dc = min(max(kc - cq + 15, 0), 30); bias = rpb[(kr - r + 7) * 31 + dc]; }
        float f1 = 1.f, p1 = 0.f, f2 = 1.f, p2 = 0.f;
        if (valid) {
            const float x1 = sa + bias;
            if (x1 > m1) { f1 = __expf(m1 - x1); m1 = x1; }
            p1 = __expf(x1 - m1);
            if (MODE == 1) { const float x2 = sb + bias; if (x2 > m2) { f2 = __expf(m2 - x2); m2 = x2; } p2 = __expf(x2 - m2); }
        }
        l1 = l1 * f1 + p1; if (MODE == 1) l2 = l2 * f2 + p2;
        { const u32x4* vp = (const u32x4*)(PROJ + (size_t)(bS + ku) * INW + vcol);
#pragma unroll
          for (int c = 0; c < NCV; ++c) { const u32x4 w = vp[c]; float v[8];
            v[0] = bf2f(w.x & 0xffffu); v[1] = bf2f(w.x >> 16); v[2] = bf2f(w.y & 0xffffu); v[3] = bf2f(w.y >> 16);
            v[4] = bf2f(w.z & 0xffffu); v[5] = bf2f(w.z >> 16); v[6] = bf2f(w.w & 0xffffu); v[7] = bf2f(w.w >> 16);
#pragma unroll
            for (int e = 0; e < 8; ++e) { o1[8 * c + e] = o1[8 * c + e] * f1 + p1 * v[e]; if (MODE == 1) o2[8 * c + e] = o2[8 * c + e] * f2 + p2 * v[e]; } } }
    }
    const float inv1 = 1.f / l1;
    if (MODE == 1) {
        const float lam = ((const float*)(P.ws + WS_LAM))[l], lam_init = ((const float*)(P.ws + WS_LAM))[4 + l];
        const float inv2 = lam / l2; float ss = 0.f;
#pragma unroll
        for (int d = 0; d < NDV; ++d) { o1[d] = o1[d] * inv1 - o2[d] * inv2; ss += o1[d] * o1[d]; }
        ss += __shfl_xor(ss, 1);
        const float rn = (1.f / sqrtf(ss * (1.f / 64.f) + LN_EPS)) * (1.f - lam_init);
#pragma unroll
        for (int d = 0; d < NDV; ++d) o1[d] = o1[d] * rn * P.subln[l * 64 + dh * 32 + d];
    } else {
#pragma unroll
        for (int d = 0; d < NDV; ++d) o1[d] *= inv1;
    }
    u32x4* op = (u32x4*)(YC + (size_t)t * DM + ocol);
#pragma unroll
    for (int c = 0; c < NCV; ++c) { u32x4 w; w.x = pk2(o1[8 * c], o1[8 * c + 1]); w.y = pk2(o1[8 * c + 2], o1[8 * c + 3]); w.z = pk2(o1[8 * c + 4], o1[8 * c + 5]); w.w = pk2(o1[8 * c + 6], o1[8 * c + 7]); op[c] = w; }
}

typedef short v4i16 __attribute__((ext_vector_type(4)));
__device__ __forceinline__ v4i16 vtr(const LAS unsigned char* p) { return __builtin_amdgcn_ds_read_tr16_b64_v4i16((LAS v4i16*)p); }
__device__ __forceinline__ int crow(int r, int hi) { return (r & 3) + 8 * (r >> 2) + 4 * hi; }
__device__ __forceinline__ unsigned cvtpk(float lo, float hi) { unsigned r; asm volatile("v_cvt_pk_bf16_f32 %0, %1, %2" : "=v"(r) : "v"(lo), "v"(hi)); return r; }
constexpr int AT_KROW = 144, AT_KBUF = 64 * AT_KROW, AT_VOFF = 2 * AT_KBUF, AT_VBUF = 8192, AT_LUT = 36864, AT_XCH = 40960;
constexpr float LOG2E = 1.4426950408889634f;

template <int MODE  >
__device__ __forceinline__ void attn_unit(const Params& P, const bf16_t* PROJ, bf16_t* YC, LAS unsigned char* lds, int l, int u, int tid) {
    constexpr int DSM = (MODE == 1) ? 2 : 4;
    const int lane = tid & 63, r32 = lane & 31, hi = lane >> 5, wid = __builtin_amdgcn_readfirstlane(tid >> 6);
    int b, h, qcol, kcol, vcol, ocol, kbase, t_lo, t_hi, qpos;
    int w_lo, w_hi;
    int qwu = 0, ds0 = 0;
    int cr = 0, ckr_lo = 0;
    float cscale;
    if (MODE == 0) {
        b = u / 96; const int rem = u % 96; h = rem >> 4; const int q0 = (rem & 15) * 256;
        qcol = QA + 64 * h; kcol = KA + 64 * (h / 3); vcol = VA + 64 * (h / 3); ocol = 64 * h; cscale = 0.125f * LOG2E;
        kbase = q0 - 128; t_lo = (q0 == 0) ? 2 : 0; t_hi = (q0 == SEQ - 256) ? 5 : 7;
        const int qw = q0 + 32 * wid; qpos = qw + r32;
        w_lo = (qw - 128 - kbase) >> 6; w_hi = (qw + 159 - kbase) >> 6;
    } else if (MODE == 1) {
        b = u >> 7; h = (u >> 5) & 3; const int q0 = (u & 31) * 128; ds0 = 2 * (wid & 1);
        qcol = QB + 64 * h; kcol = KB + 64 * h; vcol = VB + 64 * h; ocol = 384 + 64 * h; cscale = 0.17677669529663687f * LOG2E;
        kbase = 0; t_lo = 0; t_hi = 63; qwu = q0 + 32 * (wid >> 1); qpos = qwu + r32; w_lo = 0; w_hi = 63;
    } else {
        b = u / 96; const int rem = u % 96; h = rem >> 4; const int r0 = 4 * (rem & 15);
        qcol = QC + 64 * h; kcol = KC + 64 * h; vcol = VC + 64 * h; ocol = 640 + 64 * h; cscale = 0.125f * LOG2E;
        cr = r0 + (wid >> 1); qpos = 64 * cr + 32 * (wid & 1) + r32;
        ckr_lo = min(max(r0 - 4, 0), 56); const int kr_hi = min(max(r0 - 1, 0), 56) + 7;
        kbase = 64 * ckr_lo; t_lo = 0; t_hi = kr_hi - ckr_lo;
        const int crs = min(max(cr - 4, 0), 56); w_lo = crs - ckr_lo; w_hi = w_lo + 7;
    }
    const size_t tokb = (size_t)b * SEQ;
    LAS float* lut = (LAS float*)(lds + AT_LUT);
    if (MODE == 2) { const float* rp = P.rpb + ((size_t)l * 6 + h) * 465; if (tid < 465) lut[tid] = rp[tid] * LOG2E; }
    else { const int col = (MODE == 0) ? h : 6 + h; if (tid < 257) lut[tid] = P.t5[t5_bucket(tid - 128) * 10 + col] * LOG2E; }
    float far_neg = 0.f, far_pos = 0.f;
    if (MODE == 1) { far_neg = P.t5[15 * 10 + 6 + h] * LOG2E; far_pos = P.t5[31 * 10 + 6 + h] * LOG2E; }
    bf16x8 qf[DSM];
    { const bf16_t* qp = PROJ + (tokb + qpos) * INW + qcol + 8 * hi + 16 * ds0;
#pragma unroll
      for (int ds = 0; ds < DSM; ++ds) qf[ds] = *(const bf16x8*)(qp + 16 * ds); }
    float mrun = -INFINITY, lrun = 0.f; f32x16 O[2];
#pragma unroll
    for (int d = 0; d < 2; ++d)
#pragma unroll
        for (int r = 0; r < 16; ++r) O[d][r] = 0.f;
    if (MODE == 0) { mrun = P.sink[l * 6 + h] * LOG2E; lrun = (hi == 0) ? 1.f : 0.f; }
    const int skey = tid >> 3, sc = tid & 7;
    const bf16_t* gk = PROJ + (tokb + kbase + skey) * INW + kcol + 8 * sc;
    const int gvo = vcol - kcol;
    const int kwr = skey * AT_KROW + sc * 16, vwr = AT_VOFF + (sc >> 2) * 4096 + skey * 64 + (sc & 3) * 16;
    const int krd = r32 * AT_KROW + hi * 16 + ds0 * 32;
    const int vrd = AT_VOFF + (4 * hi + ((lane & 15) >> 2)) * 64 + ((lane >> 4) & 1) * 32 + (lane & 3) * 8;
    u32x4 rk = *(const u32x4*)(gk + (size_t)t_lo * 64 * INW), rv = *(const u32x4*)(gk + (size_t)t_lo * 64 * INW + gvo);
    *(LAS u32x4*)(lds + kwr) = rk; *(LAS u32x4*)(lds + vwr) = rv;
    __syncthreads();
    int cur = 0;
#pragma unroll 1
    for (int t = t_lo; t <= t_hi; ++t) {
        { const int tn = min(t + 1, t_hi); const bf16_t* gp = gk + (size_t)tn * 64 * INW; rk = *(const u32x4*)gp; rv = *(const u32x4*)(gp + gvo); }
        if (t >= w_lo && t <= w_hi) {
            const LAS unsigned char* Kb = lds + cur * AT_KBUF + krd; const LAS unsigned char* Vb = lds + cur * AT_VBUF + vrd;
            const int ks = kbase + 64 * t;
            int hi_ = hi, qpos_ = qpos; asm volatile("" : "+v"(hi_), "+v"(qpos_));
            bf16x8 pf[4];
            f32x16 s0, s1;
#pragma unroll
            for (int r = 0; r < 16; ++r) { s0[r] = 0.f; s1[r] = 0.f; }
#pragma unroll
            for (int dsi = 0; dsi < DSM; ++dsi) {
                const bf16x8 k0 = *(const LAS bf16x8*)(Kb + dsi * 32), k1 = *(const LAS bf16x8*)(Kb + 32 * AT_KROW + dsi * 32);
                s0 = __builtin_amdgcn_mfma_f32_32x32x16_bf16(k0, qf[dsi], s0, 0, 0, 0);
                s1 = __builtin_amdgcn_mfma_f32_32x32x16_bf16(k1, qf[dsi], s1, 0, 0, 0); }
            if (MODE == 0) {
#pragma unroll
                for (int r = 0; r < 16; ++r) { const int rel0 = ks + crow(r, hi_) - qpos_, rel1 = rel0 + 32;
                    const float b0 = lut[min(max(rel0 + 128, 0), 256)], b1 = lut[min(max(rel1 + 128, 0), 256)];
                    s0[r] = (rel0 >= -128 && rel0 <= 128) ? s0[r] * cscale + b0 : -INFINITY;
                    s1[r] = (rel1 >= -128 && rel1 <= 128) ? s1[r] * cscale + b1 : -INFINITY; }
            } else if (MODE == 1) {
                if (ks + 63 - qwu <= -91) {
#pragma unroll
                    for (int r = 0; r < 16; ++r) { s0[r] = s0[r] * cscale + far_neg; s1[r] = s1[r] * cscale + far_neg; }
                } else if (ks - (qwu + 31) >= 91) {
#pragma unroll
                    for (int r = 0; r < 16; ++r) { s0[r] = s0[r] * cscale + far_pos; s1[r] = s1[r] * cscale + far_pos; }
                } else {
#pragma unroll
                    for (int r = 0; r < 16; ++r) { const int rel0 = ks + crow(r, hi_) - qpos_, rel1 = rel0 + 32;
                        s0[r] = s0[r] * cscale + lut[min(max(rel0 + 128, 0), 256)]; s1[r] = s1[r] * cscale + lut[min(max(rel1 + 128, 0), 256)]; }
                }
            } else {
                const int qc = qpos_ & 63, cstart = min(max(qc - 8, 0), 48); const int drow = (ckr_lo + t - cr + 7) * 31;
#pragma unroll
                for (int r = 0; r < 16; ++r) { const int kc0 = crow(r, hi_), kc1 = kc0 + 32;
                    const float b0 = lut[drow + min(max(kc0 - qc + 15, 0), 30)], b1 = lut[drow + min(max(kc1 - qc + 15, 0), 30)];
                    s0[r] = (kc0 >= cstart && kc0 < cstart + 16) ? s0[r] * cscale + b0 : -INFINITY;
                    s1[r] = (kc1 >= cstart && kc1 < cstart + 16) ? s1[r] * cscale + b1 : -INFINITY; }
            }
            float mx = fmaxf(s0[0], s1[0]);
#pragma unroll
            for (int r = 1; r < 16; ++r) mx = fmaxf(mx, fmaxf(s0[r], s1[r]));
            mx = fmaxf(mx, __shfl_xor(mx, 32));
            const float mn = fmaxf(mrun, mx), alpha = __builtin_amdgcn_exp2f(mrun - mn); mrun = mn;
            float rsum = 0.f;
#pragma unroll
            for (int r = 0; r < 16; ++r) { s0[r] = __builtin_amdgcn_exp2f(s0[r] - mn); s1[r] = __builtin_amdgcn_exp2f(s1[r] - mn); rsum += s0[r] + s1[r]; }
            lrun = lrun * alpha + rsum;
#pragma unroll
            for (int d = 0; d < 2; ++d)
#pragma unroll
                for (int r = 0; r < 16; ++r) O[d][r] *= alpha;
#pragma unroll
            for (int sidx = 0; sidx < 2; ++sidx) {
                u32x4 w0, w1;
                w0.x = cvtpk(s0[8 * sidx + 0], s0[8 * sidx + 1]); w0.y = cvtpk(s0[8 * sidx + 2], s0[8 * sidx + 3]); w0.z = cvtpk(s0[8 * sidx + 4], s0[8 * sidx + 5]); w0.w = cvtpk(s0[8 * sidx + 6], s0[8 * sidx + 7]);
                w1.x = cvtpk(s1[8 * sidx + 0], s1[8 * sidx + 1]); w1.y = cvtpk(s1[8 * sidx + 2], s1[8 * sidx + 3]); w1.z = cvtpk(s1[8 * sidx + 4], s1[8 * sidx + 5]); w1.w = cvtpk(s1[8 * sidx + 6], s1[8 * sidx + 7]);
                pf[sidx] = __builtin_bit_cast(bf16x8, w0); pf[2 + sidx] = __builtin_bit_cast(bf16x8, w1); }
#pragma unroll
            for (int dblk = 0; dblk < 2; ++dblk)
#pragma unroll
                for (int k4 = 0; k4 < 4; ++k4) {
                    const v4i16 lo = vtr(Vb + dblk * 4096 + k4 * 1024), up = vtr(Vb + dblk * 4096 + k4 * 1024 + 512);
                    const bf16x8 vf = (bf16x8){lo[0], lo[1], lo[2], lo[3], up[0], up[1], up[2], up[3]};
                    O[dblk] = __builtin_amdgcn_mfma_f32_32x32x16_bf16(vf, pf[k4], O[dblk], 0, 0, 0);
                }
        }
        *(LAS u32x4*)(lds + (cur ^ 1) * AT_KBUF + kwr) = rk; *(LAS u32x4*)(lds + (cur ^ 1) * AT_VBUF + vwr) = rv;
        __syncthreads();
        cur ^= 1;
    }
    bf16_t* op = YC + (tokb + qpos) * DM + ocol + 4 * hi;
    const float lt = lrun + __shfl_xor(lrun, 32);
    if (MODE == 1) {
        const float lam = ((const float*)(P.ws + WS_LAM))[l], lam_init = ((const float*)(P.ws + WS_LAM))[4 + l];
        LAS float* xch = (LAS float*)(lds + AT_XCH) + (wid >> 1) * 2048 + lane;
        if (wid & 1) { const float i2 = lam / lt;
#pragma unroll
            for (int d = 0; d < 2; ++d)
#pragma unroll
                for (int r = 0; r < 16; ++r) xch[(d * 16 + r) * 64] = O[d][r] * i2; }
        __syncthreads();
        if (!(wid & 1)) {
            const float i1 = 1.f / lt; float ss = 0.f;
#pragma unroll
            for (int d = 0; d < 2; ++d)
#pragma unroll
                for (int r = 0; r < 16; ++r) { const float o = O[d][r] * i1 - xch[(d * 16 + r) * 64]; O[d][r] = o; ss += o * o; }
            ss += __shfl_xor(ss, 32);
            const float rn = (1.f / sqrtf(ss * (1.f / 64.f) + LN_EPS)) * (1.f - lam_init);
            const float* sg = P.subln + l * 64 + 4 * hi;
#pragma unroll
            for (int d = 0; d < 2; ++d)
#pragma unroll
                for (int g4 = 0; g4 < 4; ++g4) { const f32x4 gg = *(const f32x4*)(sg + 32 * d + 8 * g4);
                    u32x2 w; w.x = cvtpk(O[d][4 * g4] * rn * gg.x, O[d][4 * g4 + 1] * rn * gg.y); w.y = cvtpk(O[d][4 * g4 + 2] * rn * gg.z, O[d][4 * g4 + 3] * rn * gg.w);
                    *(u32x2*)(op + 32 * d + 8 * g4) = w; }
        }
    } else {
        const float inv = 1.f / lt;
#pragma unroll
        for (int d = 0; d < 2; ++d)
#pragma unroll
            for (int g4 = 0; g4 < 4; ++g4) { u32x2 w; w.x = cvtpk(O[d][4 * g4] * inv, O[d][4 * g4 + 1] * inv); w.y = cvtpk(O[d][4 * g4 + 2] * inv, O[d][4 * g4 + 3] * inv);
                *(u32x2*)(op + 32 * d + 8 * g4) = w; }
    }
}

__global__ void __launch_bounds__(512, 2) fwd_megakernel(Params P) {
    extern __shared__ __attribute__((aligned(16))) unsigned char lds_raw[];
    LAS unsigned char* lds = (LAS unsigned char*)lds_raw;
    cg::grid_group grid = cg::this_grid();
    const int G = gridDim.x, bx = blockIdx.x, ngw = G * 8;
#define FRESH_IDS int tid = threadIdx.x; asm volatile("" : "+v"(tid)); const int lane = tid & 63, wid = __builtin_amdgcn_readfirstlane(tid >> 6), gw = bx * 8 + wid; (void)lane; (void)gw;
    unsigned char* ws = P.ws;
    float* mod = (float*)(ws + WS_MOD);
    bf16_t* HN = (bf16_t*)(ws + WS_HN); bf16_t* Y = (bf16_t*)(ws + WS_Y); bf16_t* PROJ = (bf16_t*)(ws + WS_R); bf16_t* YCAT = (bf16_t*)(ws + WS_YCAT); bf16_t* HID = (bf16_t*)(ws + WS_R);

    {
        FRESH_IDS
        LAS float* scr = (LAS float*)(lds + wid * 16384);
        constexpr int I_IN = 16 * 80, I_OUT = 16 * 32, I_1 = 16 * 128, I_2 = 64 * 32, I_L = I_IN + I_OUT + I_1 + I_2;
        for (int it = gw; it < DEPTH * I_L; it += ngw) {
            const int l = it / I_L; int r = it % I_L;
            if (r < I_IN) { transpose_item(P.w_in + (size_t)l * DM * INW, DM, INW, (bf16_t*)(ws + WS_WIN) + (size_t)l * INW * DM, scr, r, lane); continue; } r -= I_IN;
            if (r < I_OUT) { transpose_item(P.w_out + (size_t)l * DM * DM, DM, DM, (bf16_t*)(ws + WS_WOUT) + (size_t)l * DM * DM, scr, r, lane); continue; } r -= I_OUT;
            if (r < I_1) { transpose_item(P.w_ff1 + (size_t)l * DM * FF, DM, FF, (bf16_t*)(ws + WS_W1) + (size_t)l * FF * DM, scr, r, lane); continue; } r -= I_1;
            transpose_item(P.w_ff2 + (size_t)l * FF * DM, FF, DM, (bf16_t*)(ws + WS_W2) + (size_t)l * DM * FF, scr, r, lane);
        }
        __syncthreads();
        for (int it = bx; it < DEPTH * 96; it += G) mod_item(P, lds, it, tid);
        if (bx == 0 && tid < DEPTH) {
            const float* lv = P.dlam + tid * 128; float a = 0.f, b = 0.f;
            for (int i = 0; i < 32; ++i) { a += lv[i] * lv[32 + i]; b += lv[64 + i] * lv[96 + i]; }
            const float lam_init = 0.8f - 0.6f * expf(-0.3f * (float)tid);
            ((float*)(ws + WS_LAM))[tid] = expf(a) - expf(b) + lam_init; ((float*)(ws + WS_LAM))[4 + tid] = lam_init;
        }
    }
    grid.sync();
    { FRESH_IDS row_pass<0>(P.x, nullptr, nullptr, HN, nullptr, nullptr, nullptr, mod + 1024, mod, gw, ngw, lane); }
    grid.sync();

#pragma unroll
    for (int l = 0; l < DEPTH; ++l) {
        const float* modl = mod + (size_t)l * 16 * 6144;
        { pg8::Gemm g{HN, (const bf16_t*)(ws + WS_WIN) + (size_t)l * INW * DM, M, INW, DM}; pg8::StaticOrder S; S.init(M, INW, G, bx);
          pg8::EpiBf16<0> E{PROJ, INW}; pg8::gemm_phase<pg8::EpiBf16<0>, pg8::StaticOrder, true, true>(lds, g, S, E); }
        grid.sync();
        {
            FRESH_IDS
            const int vcu = ((G & 7) == 0) ? (bx & 7) * (G >> 3) + (bx >> 3) : bx;
#if FAST_B
            for (int u = vcu; u < 2048; u += G) attn_unit<1>(P, PROJ, YCAT, lds, l, u, tid);
#endif
#if FAST_A
            for (int u = vcu; u < 1536; u += G) attn_unit<0>(P, PROJ, YCAT, lds, l, u, tid);
#endif
#if FAST_C
            for (int u = vcu; u < 1536; u += G) attn_unit<2>(P, PROJ, YCAT, lds, l, u, tid);
#endif
#if !(FAST_A && FAST_B && FAST_C)
            for (int task = gw; task < 1024 * 12 + 2048 * 4; task += ngw) {
                if (task < 1024 * 12) { const int hh = task % 12, tb = task / 12;
                    if (hh < 6) { if (!FAST_A) naive_attn_task<0>(P, PROJ, YCAT, l, tb, hh, lane); }
                    else { if (!FAST_C) naive_attn_task<2>(P, PROJ, YCAT, l, tb, hh - 6, lane); }
                } else { const int t2 = task - 1024 * 12; if (!FAST_B) naive_attn_task<1>(P, PROJ, YCAT, l, t2 >> 2, t2 & 3, lane); }
            }
#endif
        }
        grid.sync();
        { pg8::Gemm g{YCAT, (const bf16_t*)(ws + WS_WOUT) + (size_t)l * DM * DM, M, DM, DM}; pg8::StaticOrder S; S.init(M, DM, G, bx);
          pg8::EpiBf16<0> E{Y, DM}; pg8::gemm_phase<pg8::EpiBf16<0>, pg8::StaticOrder, true, true>(lds, g, S, E); }
        grid.sync();
        { FRESH_IDS row_pass<1>(l == 0 ? P.x : P.out, Y, P.out, HN, modl + 2048, P.ln_g + (size_t)(l * 2) * DM, P.ln_b + (size_t)(l * 2) * DM, modl + 4096, modl + 3072, gw, ngw, lane); }
        grid.sync();
        { pg8::Gemm g{HN, (const bf16_t*)(ws + WS_W1) + (size_t)l * FF * DM, M, FF, DM}; pg8::StaticOrder S; S.init(M, FF, G, bx);
          pg8::EpiBf16<2> E{HID, FF}; pg8::gemm_phase<pg8::EpiBf16<2>, pg8::StaticOrder, true, true>(lds, g, S, E); }
        grid.sync();
        { pg8::Gemm g{HID, (const bf16_t*)(ws + WS_W2) + (size_t)l * DM * FF, M, DM, FF}; pg8::StaticOrder S; S.init(M, DM, G, bx);
          pg8::EpiBf16<0> E{Y, DM}; pg8::gemm_phase<pg8::EpiBf16<0>, pg8::StaticOrder, true, true>(lds, g, S, E); }
        grid.sync();
        if (l + 1 < DEPTH) {
            const float* modn = modl + 16 * 6144;
            FRESH_IDS row_pass<1>(P.out, Y, P.out, HN, modl + 5120, P.ln_g + (size_t)(l * 2 + 1) * DM, P.ln_b + (size_t)(l * 2 + 1) * DM, modn + 1024, modn, gw, ngw, lane);
            grid.sync();
        } else {
            FRESH_IDS row_pass<2>(P.out, Y, P.out, nullptr, modl + 5120, P.ln_g + (size_t)(l * 2 + 1) * DM, P.ln_b + (size_t)(l * 2 + 1) * DM, nullptr, nullptr, gw, ngw, lane);
        }
    }
}

extern "C" void kernel_launch(void* const* d_in, const int* in_sizes, int n_in, void* d_out, int out_size, void* d_ws, size_t ws_size, hipStream_t stream) {
    static int grid = 0;
    if (grid == 0) {
        if (n_in != 15 || in_sizes[0] != M * DM || out_size != M * DM || ws_size < WS_END) { fprintf(stderr, "kernel_launch: unexpected shapes (n_in %d in0 %d out %d ws %zu)\n", n_in, n_in > 0 ? in_sizes[0] : -1, out_size, ws_size); grid = -1; return; }
        int dev = 0, cus = 0, per_cu = 0;
        hipGetDevice(&dev);
        hipDeviceGetAttribute(&cus, hipDeviceAttributeMultiprocessorCount, dev);
        if (hipFuncSetAttribute((const void*)fwd_megakernel, hipFuncAttributeMaxDynamicSharedMemorySize, LDS_BYTES) != hipSuccess) { fprintf(stderr, "kernel_launch: hipFuncSetAttribute failed\n"); grid = -1; return; }
        if (hipOccupancyMaxActiveBlocksPerMultiprocessor(&per_cu, (const void*)fwd_megakernel, 512, LDS_BYTES) != hipSuccess || per_cu < 1) { fprintf(stderr, "kernel_launch: occupancy query says %d\n", per_cu); per_cu = 1; }
        (void)hipGetLastError();
        grid = cus * 1;
    }
    if (grid < 0) return;
    Params p{};
    p.x = (const float*)d_in[0]; p.c = (const float*)d_in[1]; p.w_ada = (const float*)d_in[2]; p.b_ada = (const float*)d_in[3]; p.w_in = (const float*)d_in[4];
    p.w_out = (const float*)d_in[5]; p.t5 = (const float*)d_in[6]; p.sink = (const float*)d_in[7]; p.dlam = (const float*)d_in[8]; p.subln = (const float*)d_in[9];
    p.rpb = (const float*)d_in[10]; p.ln_g = (const float*)d_in[11]; p.ln_b = (const float*)d_in[12]; p.w_ff1 = (const float*)d_in[13]; p.w_ff2 = (const float*)d_in[14];
    p.out = (float*)d_out; p.ws = (unsigned char*)d_ws;
    void* args[] = {&p};
    hipError_t e = hipLaunchCooperativeKernel((const void*)fwd_megakernel, dim3(grid), dim3(512), args, LDS_BYTES, stream);
    if (e != hipSuccess) fprintf(stderr, "cooperative launch failed: %s (grid %d)\n", hipGetErrorString(e), grid);
}
```
